# Optimizing an MI355X kernel written in HIP

```python
import jax
import jax.numpy as jnp
from jax import lax
import numpy as np

D_MODEL = 2048
BATCH = 4
SEQ = 4096
DEPTH = 1

GRID_W = 64
CTX_LEN = 256
HEAD_DIM = 128
MIX_WIDTH = D_MODEL
A_HEADS = MIX_WIDTH // (2 * HEAD_DIM)
A_KV_HEADS = A_HEADS // 4
A_GROUP = A_HEADS // A_KV_HEADS
A_WIDTH = A_HEADS * HEAD_DIM
WINDOW = 128
A_BLOCK = 128
ROPE_THETA = 10000.0
B_WIDTH = MIX_WIDTH - A_WIDTH
B_HEADS = 4
B_DV = B_WIDTH // B_HEADS
B_DK = B_DV // 2
B_KEY_WIDTH = B_HEADS * B_DK
GATE_RANK = 16
GATE_TAU = 16.0
GLA_CHUNK = 64
IN_SPLITS = (A_WIDTH, A_KV_HEADS * HEAD_DIM, A_KV_HEADS * HEAD_DIM, B_KEY_WIDTH, B_KEY_WIDTH, B_WIDTH, B_WIDTH, 2 * GATE_RANK)
IN_WIDTH = sum(IN_SPLITS)
N_GROUPS = 4
EXPERTS_PER_GROUP = 8
N_EXPERTS = N_GROUPS * EXPERTS_PER_GROUP
TOP_K = 2
EXPERT_HIDDEN = D_MODEL // 2
MOE_BLOCK = 128
ALPHA = (2.0 * DEPTH) ** 0.25
BETA = (8.0 * DEPTH) ** -0.25
LN_EPS = 1e-6

kernel_name = 'hymba_style_gqa_gla_hmoe_dit_layer'


def layer_norm(x, gain=None, bias=None):
    xf = x.astype(jnp.float32)
    mu = jnp.mean(xf, axis=-1, keepdims=True)
    var = jnp.mean(jnp.square(xf - mu), axis=-1, keepdims=True)
    y = (xf - mu) * lax.rsqrt(var + LN_EPS)
    if gain is not None:
        y = y * gain.astype(jnp.float32) + bias.astype(jnp.float32)
    return y.astype(x.dtype)


def modulate(x, shift, scale):
    return layer_norm(x) * (1 + scale) + shift


def heads(t, n):
    return t.reshape(t.shape[:-1] + (n, t.shape[-1] // n))


def flip(t):
    return t[:, ::-1]


def axial_rope(rows, dtype):
    n_freq = HEAD_DIM // 4
    inv_freq = ROPE_THETA ** (-jnp.arange(n_freq, dtype=jnp.float32) / n_freq)
    row = jnp.repeat(jnp.arange(rows, dtype=jnp.float32), GRID_W)
    col = jnp.tile(jnp.arange(GRID_W, dtype=jnp.float32), rows)
    ang = jnp.stack([row[:, None] * inv_freq, col[:, None] * inv_freq], axis=1)
    return jnp.cos(ang)[:, None].astype(dtype), jnp.sin(ang)[:, None].astype(dtype)


def apply_rope(t, cos, sin):
    tr = t.reshape(t.shape[:-1] + (2, 2, HEAD_DIM // 4))
    t1, t2 = tr[..., 0, :], tr[..., 1, :]
    return jnp.stack([t1 * cos - t2 * sin, t2 * cos + t1 * sin], axis=-2).reshape(t.shape)


def windowed_gqa(q, k, v, k_ctx, v_ctx, sink):
    B, S = q.shape[:2]
    L = k_ctx.shape[1]
    nb = S // A_BLOCK
    scale = HEAD_DIM ** -0.5
    qb = q.reshape(B, nb, A_BLOCK, A_KV_HEADS, A_GROUP, HEAD_DIM)
    pad = ((0, 0), (A_BLOCK, A_BLOCK), (0, 0), (0, 0))
    kp = jnp.pad(k, pad).reshape(B, nb + 2, A_BLOCK, A_KV_HEADS, HEAD_DIM)
    vp = jnp.pad(v, pad).reshape(B, nb + 2, A_BLOCK, A_KV_HEADS, HEAD_DIM)
    band = lambda t: jnp.concatenate([t[:, :-2], t[:, 1:-1], t[:, 2:]], axis=2)
    kb, vb = band(kp), band(vp)
    s_band = jnp.einsum('bnqhgd,bnkhd->bnhgqk', qb, kb).astype(jnp.float32) * scale
    blk = jnp.arange(nb)[:, None] * A_BLOCK
    qpos = blk + jnp.arange(A_BLOCK)[None, :]
    kpos = blk - A_BLOCK + jnp.arange(3 * A_BLOCK)[None, :]
    rel = kpos[:, None, :] - qpos[:, :, None]
    valid = (jnp.abs(rel) <= WINDOW) & (kpos[:, None, :] >= 0) & (kpos[:, None, :] < S)
    s_band = jnp.where(valid[None, :, None, None], s_band, -jnp.inf)
    s_ctx = jnp.einsum('bnqhgd,blhd->bnhgql', qb, k_ctx).astype(jnp.float32) * scale
    sink_l = jnp.broadcast_to(sink.astype(jnp.float32).reshape(A_KV_HEADS, A_GROUP)[None, None, :, :, None, None], (B, nb, A_KV_HEADS, A_GROUP, A_BLOCK, 1))
    p = jax.nn.softmax(jnp.concatenate([sink_l, s_ctx, s_band], axis=-1), axis=-1).astype(v.dtype)
    out = jnp.einsum('bnhgql,blhd->bnqhgd', p[..., 1:1 + L], v_ctx) + jnp.einsum('bnhgqk,bnkhd->bnqhgd', p[..., 1 + L:], vb)
    return out.reshape(B, S, A_WIDTH)


def context_attention(q_ctx, k_ctx, v_ctx, sink):
    B, L = q_ctx.shape[:2]
    qg = q_ctx.reshape(B, L, A_KV_HEADS, A_GROUP, HEAD_DIM)
    s = jnp.einsum('blhgd,bmhd->bhglm', qg, k_ctx).astype(jnp.float32) * HEAD_DIM ** -0.5
    sink_l = jnp.broadcast_to(sink.astype(jnp.float32).reshape(A_KV_HEADS, A_GROUP)[None, :, :, None, None], (B, A_KV_HEADS, A_GROUP, L, 1))
    p = jax.nn.softmax(jnp.concatenate([sink_l, s], axis=-1), axis=-1).astype(v_ctx.dtype)
    out = jnp.einsum('bhglm,bmhd->blhgd', p[..., 1:], v_ctx)
    return out.reshape(B, L, A_WIDTH)


def gla_log_decay(g_low, w_up, b_up):
    z = (g_low @ w_up + b_up).astype(jnp.float32)
    return heads(jax.nn.log_sigmoid(z) / GATE_TAU, B_HEADS)


def gla_chunked(q, k, v, log_a, state0):
    B, N, H, dk = q.shape
    nc = N // GLA_CHUNK
    chunks = lambda t: t.astype(jnp.float32).reshape(B, nc, GLA_CHUNK, H, t.shape[-1]).transpose(0, 1, 3, 2, 4)
    qc, kc, vc, gc = chunks(q) * dk ** -0.5, chunks(k), chunks(v), chunks(log_a)
    b = jnp.cumsum(gc, axis=3)
    b_last = b[:, :, :, -1:]
    b_mid = b[:, :, :, GLA_CHUNK // 2 - 1:GLA_CHUNK // 2]
    qm = qc * jnp.exp(b - b_mid)
    km = kc * jnp.exp(b_mid - b)
    tri = jnp.tril(jnp.ones((GLA_CHUNK, GLA_CHUNK), dtype=bool))
    a_intra = jnp.where(tri, jnp.einsum('bnhtd,bnhsd->bnhts', qm, km), 0.0)
    o_intra = jnp.einsum('bnhts,bnhsv->bnhtv', a_intra, vc)
    kv = jnp.einsum('bnhsd,bnhsv->bnhdv', kc * jnp.exp(b_last - b), vc)
    decay = jnp.exp(b_last[:, :, :, 0])

    def step(s, inp):
        d, kv_c = inp
        return d[..., None] * s + kv_c, s

    s_final, s_prev = lax.scan(step, state0, (decay.transpose(1, 0, 2, 3), kv.transpose(1, 0, 2, 3, 4)))
    s_prev = s_prev.transpose(1, 0, 2, 3, 4)
    o_inter = jnp.einsum('bnhtd,bnhdv->bnhtv', qc * jnp.exp(b), s_prev)
    o = (o_intra + o_inter).transpose(0, 1, 3, 2, 4).reshape(B, N, H, v.shape[-1])
    return o.astype(v.dtype), s_final


def gla_output(o, r, norm_w):
    of = o.astype(jnp.float32)
    of = of * lax.rsqrt(jnp.mean(jnp.square(of), axis=-1, keepdims=True) + LN_EPS)
    of = of.reshape(o.shape[:2] + (B_WIDTH,)) * norm_w.astype(jnp.float32)
    return of.astype(r.dtype) * jax.nn.silu(r)


def mixing_sublayer(h, h_ctx, cos, sin, w_in, w_gate_up, b_gate, sink, norm_w, w_out, need_ctx):
    split_at = [int(s) for s in np.cumsum(IN_SPLITS)[:-1]]
    qa, ka, va, qb, kb, vb, rb, gb = jnp.split(h @ w_in, split_at, axis=-1)
    qa_c, ka_c, va_c, qb_c, kb_c, vb_c, rb_c, gb_c = jnp.split(h_ctx @ w_in, split_at, axis=-1)
    qa = apply_rope(heads(qa, A_HEADS), cos, sin)
    ka = apply_rope(heads(ka, A_KV_HEADS), cos, sin)
    va = heads(va, A_KV_HEADS)
    ka_c, va_c = heads(ka_c, A_KV_HEADS), heads(va_c, A_KV_HEADS)
    out_a = windowed_gqa(qa, ka, va, ka_c, va_c, sink)
    qb, kb, vb = heads(qb, B_HEADS), heads(kb, B_HEADS), heads(vb, B_HEADS)
    qb_c, kb_c, vb_c = heads(qb_c, B_HEADS), heads(kb_c, B_HEADS), heads(vb_c, B_HEADS)
    la_f = gla_log_decay(gb[..., :GATE_RANK], w_gate_up[0], b_gate[0])
    la_b = gla_log_decay(gb[..., GATE_RANK:], w_gate_up[1], b_gate[1])
    lac_f = gla_log_decay(gb_c[..., :GATE_RANK], w_gate_up[0], b_gate[0])
    lac_b = gla_log_decay(gb_c[..., GATE_RANK:], w_gate_up[1], b_gate[1])
    s0 = jnp.zeros((h.shape[0], B_HEADS, B_DK, B_DV), jnp.float32)
    oc_f, sc_f = gla_chunked(qb_c, kb_c, vb_c, lac_f, s0)
    oc_b, sc_b = gla_chunked(flip(qb_c), flip(kb_c), flip(vb_c), flip(lac_b), s0)
    o_f, _ = gla_chunked(qb, kb, vb, la_f, sc_f)
    o_b, _ = gla_chunked(flip(qb), flip(kb), flip(vb), flip(la_b), sc_b)
    out_b = gla_output(o_f + flip(o_b), rb, norm_w)
    y = jnp.concatenate([out_a, out_b], axis=-1) @ w_out
    if not need_ctx:
        return y, None
    out_a_c = context_attention(heads(qa_c, A_HEADS), ka_c, va_c, sink)
    out_b_c = gla_output(oc_f + flip(oc_b), rb_c, norm_w)
    y_ctx = jnp.concatenate([out_a_c, out_b_c], axis=-1) @ w_out
    return y, y_ctx


def hier_moe(h, w_rg, b_rg, w_re, b_re, w_gate, w_up, w_down):
    T, D = h.shape
    pg = jax.nn.softmax((h @ w_rg).astype(jnp.float32) + b_rg.astype(jnp.float32), axis=-1)
    pg_top, grp = lax.top_k(pg, 1)
    el = ((h @ w_re).astype(jnp.float32) + b_re.astype(jnp.float32)).reshape(T, N_GROUPS, EXPERTS_PER_GROUP)
    el = jnp.take_along_axis(el, grp[:, :, None], axis=1)[:, 0]
    top_p, top_i = lax.top_k(jax.nn.softmax(el, axis=-1), TOP_K)
    weights = pg_top * top_p / jnp.sum(top_p, axis=-1, keepdims=True)
    expert_id = (grp * EXPERTS_PER_GROUP + top_i).reshape(-1)
    M = T * TOP_K
    token = jnp.arange(M) // TOP_K
    order = jnp.argsort(expert_id, stable=True)
    e_sorted = expert_id[order]
    counts = jnp.zeros((N_EXPERTS,), jnp.int32).at[expert_id].add(1)
    start = jnp.cumsum(counts) - counts
    padded = (counts + MOE_BLOCK - 1) // MOE_BLOCK * MOE_BLOCK
    pad_end = jnp.cumsum(padded)
    pad_start = pad_end - padded
    dest = pad_start[e_sorted] + jnp.arange(M) - start[e_sorted]
    n_blocks = -(-M // MOE_BLOCK) + N_EXPERTS
    buf = jnp.zeros((n_blocks * MOE_BLOCK, D), h.dtype).at[dest].set(h[token[order]])
    block_e = jnp.minimum(jnp.searchsorted(pad_end, jnp.arange(n_blocks) * MOE_BLOCK, side='right'), N_EXPERTS - 1)

    def expert_block(args):
        xb, e = args
        return (jax.nn.silu(xb @ w_gate[e]) * (xb @ w_up[e])) @ w_down[e]

    out = lax.map(expert_block, (buf.reshape(n_blocks, MOE_BLOCK, D), block_e)).reshape(-1, D)
    w_sorted = weights.reshape(-1)[order].astype(h.dtype)
    return jax.ops.segment_sum(out[dest] * w_sorted[:, None], token[order], num_segments=T)


def setup_inputs(seed: int = 0) -> dict:
    key = jax.random.key(seed)
    ks = jax.random.split(key, 24)
    n = lambda k, shape, s: jax.random.normal(k, shape, jnp.float32) * s
    D = D_MODEL
    return {
        'x': n(ks[0], (BATCH, SEQ, D), 1.0),
        'c': n(ks[1], (BATCH, D), 1.0),
        'ctx': n(ks[2], (BATCH, CTX_LEN, D), 1.0),
        'c_ctx': n(ks[3], (D,), 1.0),
        'w_ada': n(ks[4], (DEPTH, D, 6 * D), D ** -0.5),
        'b_ada': n(ks[5], (DEPTH, 6 * D), 0.02),
        'w_in': n(ks[6], (DEPTH, D, IN_WIDTH), D ** -0.5),
        'w_gate_up': n(ks[7], (DEPTH, 2, GATE_RANK, B_KEY_WIDTH), GATE_RANK ** -0.5),
        'b_gate': n(ks[8], (DEPTH, 2, B_KEY_WIDTH), 0.1),
        'attn_sink': n(ks[9], (DEPTH, A_HEADS), 1.0),
        'gla_norm_w': 1.0 + n(ks[10], (DEPTH, B_WIDTH), 0.02),
        'w_out': n(ks[11], (DEPTH, MIX_WIDTH, D), MIX_WIDTH ** -0.5 * BETA),
        'ln1_g': 1.0 + n(ks[12], (DEPTH, D), 0.02),
        'ln1_b': n(ks[13], (DEPTH, D), 0.02),
        'w_router_group': n(ks[14], (DEPTH, D, N_GROUPS), D ** -0.5),
        'b_router_group': n(ks[15], (DEPTH, N_GROUPS), 0.01),
        'w_router_expert': n(ks[16], (DEPTH, D, N_EXPERTS), D ** -0.5),
        'b_router_expert': n(ks[17], (DEPTH, N_EXPERTS), 0.01),
        'w_exp_gate': n(ks[18], (DEPTH, N_EXPERTS, D, EXPERT_HIDDEN), D ** -0.5),
        'w_exp_up': n(ks[19], (DEPTH, N_EXPERTS, D, EXPERT_HIDDEN), D ** -0.5),
        'w_exp_down': n(ks[20], (DEPTH, N_EXPERTS, EXPERT_HIDDEN, D), EXPERT_HIDDEN ** -0.5 * BETA),
        'ln2_g': 1.0 + n(ks[21], (DEPTH, D), 0.02),
        'ln2_b': n(ks[22], (DEPTH, D), 0.02),
    }


def reference(x, c, ctx, c_ctx, w_ada, b_ada, w_in, w_gate_up, b_gate, attn_sink, gla_norm_w, w_out, ln1_g, ln1_b, w_router_group, b_router_group, w_router_expert, b_router_expert, w_exp_gate, w_exp_up, w_exp_down, ln2_g, ln2_b):
    B, S, D = x.shape
    L = ctx.shape[1]
    rows = S // GRID_W
    cos, sin = axial_rope(rows, x.dtype)
    for layer in range(DEPTH):
        need_ctx = layer + 1 < DEPTH
        mod = jax.nn.silu(c) @ w_ada[layer] + b_ada[layer]
        mod_c = jax.nn.silu(c_ctx) @ w_ada[layer] + b_ada[layer]
        sh1, sc1, g1, sh2, sc2, g2 = jnp.split(mod[:, None, :], 6, axis=-1)
        csh1, csc1, cg1, csh2, csc2, cg2 = jnp.split(mod_c, 6, axis=-1)
        h = modulate(x, sh1, sc1)
        h_c = modulate(ctx, csh1, csc1)
        y, y_c = mixing_sublayer(h, h_c, cos, sin, w_in[layer], w_gate_up[layer], b_gate[layer], attn_sink[layer], gla_norm_w[layer], w_out[layer], need_ctx)
        x = layer_norm(ALPHA * x + g1 * y, ln1_g[layer], ln1_b[layer])
        h = modulate(x, sh2, sc2).reshape(B * S, D)
        moe_args = (w_router_group[layer], b_router_group[layer], w_router_expert[layer], b_router_expert[layer], w_exp_gate[layer], w_exp_up[layer], w_exp_down[layer])
        if need_ctx:
            ctx = layer_norm(ALPHA * ctx + cg1 * y_c, ln1_g[layer], ln1_b[layer])
            h_c = modulate(ctx, csh2, csc2).reshape(B * L, D)
            f = hier_moe(jnp.concatenate([h_c, h], axis=0), *moe_args)
            ctx = layer_norm(ALPHA * ctx + cg2 * f[:B * L].reshape(B, L, D), ln2_g[layer], ln2_b[layer])
            f_x = f[B * L:]
        else:
            f_x = hier_moe(h, *moe_args)
        x = layer_norm(ALPHA * x + g2 * f_x.reshape(B, S, D), ln2_g[layer], ln2_b[layer])
    return x
```

```cpp
#include <hip/hip_runtime.h>
#include <cstdio>
#include <cstdint>

#ifndef MK_N_LAUNCHES
#define MK_N_LAUNCHES 1
#endif

namespace pg8 {
#define PG8_LAS __attribute__((address_space(3)))
typedef unsigned short bf16_t;
typedef short bf16x8 __attribute__((ext_vector_type(8)));
typedef float f32x4 __attribute__((ext_vector_type(4)));
typedef unsigned u32x4 __attribute__((ext_vector_type(4)));
typedef int v4i_t __attribute__((ext_vector_type(4)));
typedef int v8i_t __attribute__((ext_vector_type(8)));
constexpr int BM = 256, BK = 64, HALF = 128, HTB = HALF * BK * 2  , STAGE_BYTES = 8 * HTB, NXCD = 8, WGM = 8;

__host__ __device__ __forceinline__ int lds_byte(int r, int c) { const int st = (r >> 4) * 2 + (c >> 5), rr = r & 15, cc = c & 31, ob = rr * 64 + cc * 2; return st * 1024 + (ob ^ (((ob >> 9) & 1) << 5)); }
__host__ __device__ __forceinline__ void stage_rc(int b, int& R, int& C) { const int st = b / 1024, sb = b % 1024, swz = sb ^ (((sb >> 9) & 1) << 5); R = (st >> 1) * 16 + swz / 64; C = (st & 1) * 32 + (swz % 64) / 2; }
__host__ __device__ __forceinline__ int perm32(int rho) { const int n = rho >> 4, i = rho & 15; return 8 * (i >> 2) + 4 * n + (i & 3); }

struct Unit { int pm, pn, e; };
struct Gemm { const bf16_t* A; const bf16_t* Bt; int M, N, K; size_t bstride; };

struct StaticOrder {
    static constexpr bool GATHER = false;
    int nM, nN, nwg, G, c;
    __host__ __device__ void init(int M, int N, int G_, int c_) { nM = M / BM; nN = N / BM; nwg = nM * nN; G = G_; c = c_; }
    __host__ __device__ bool next(int i, Unit& u) const {
        const long L = (long)i * G + c; if (L >= nwg) return false;
        int wgid = (int)L; { const int q = nwg / NXCD, r = nwg % NXCD, xcd = wgid % NXCD, off = wgid / NXCD; wgid = (xcd < r ? xcd * (q + 1) : r * (q + 1) + (xcd - r) * q) + off; }
        const int nig = WGM * nN, gid = wgid / nig, fm = gid * WGM, gsz = (nM - fm) < WGM ? (nM - fm) : WGM;
        u.pm = fm + ((wgid % nig) % gsz); u.pn = (wgid % nig) / gsz; u.e = 0; return true;
    }
    __device__ __forceinline__ void a_ready(const Unit&) const {}
    __device__ __forceinline__ void done(const Unit&) const {}
};
__device__ __forceinline__ unsigned cvt_pk_bf16(float lo, float hi) { unsigned r; asm volatile("v_cvt_pk_bf16_f32 %0, %1, %2" : "=v"(r) : "v"(lo), "v"(hi)); return r; }
template <class Epi, class Sched, bool ALIGN_EPI = false, bool SP2 = false, bool FP8 = false>
__device__ __forceinline__ void gemm_phase(PG8_LAS unsigned char* lds, const Gemm g, const Sched& S, const Epi& E) {
    int tzs_ = threadIdx.x; asm volatile("" : "+v"(tzs_));
    const int tid = tzs_, wid = __builtin_amdgcn_readfirstlane(tid >> 6), lane = tid & 63, wr = wid >> 2, wc = wid & 3, fr = lane & 15, fq = lane >> 4;
    const int K = g.K, nt = K / BK;
    unsigned voffA[2], voffB[2];
#pragma unroll
    for (int i = 0; i < 2; ++i) { int R, C; stage_rc(tid * 16 + i * 8192, R, C); const int Rb = Epi::PERM ? ((R & ~31) + perm32(R & 31)) : R;
        voffA[i] = (unsigned)(R * K + C) * 2u; voffB[i] = (unsigned)(Rb * K + C) * 2u; }
    const size_t kstep = (size_t)(BK * 2);
    const size_t hstep = (size_t)HALF * K * 2;
    constexpr bool GATHER = Sched::GATHER; static_assert(!GATHER || SP2, "the row-table re-read sits in front of an lgkmcnt(0) wait only in the SP2 schedule");
    unsigned cv[2][2]; int rA[2]; unsigned cA2[2];
#pragma unroll
    for (int i = 0; i < 2; ++i) { int R, C; stage_rc(tid * 16 + i * 8192, R, C); rA[i] = R; cA2[i] = (unsigned)C * 2u; }
#define PG8_ROWS(dst, ui_) do { if constexpr (GATHER) { _Pragma("unroll") for (int h = 0; h < 2; ++h) _Pragma("unroll") for (int i = 0; i < 2; ++i) dst[h][i] = (unsigned)S.rows[(ui_) * 256 + 128 * h + rA[i]] + cA2[i]; } } while (0)

    const size_t tstep = 2 * hstep;
    const unsigned ldsw = (unsigned)wid * 1024u;
    const int aoff = lds_byte(wr * 64 + fr, fq * 8), boff = lds_byte(wc * 32 + fr, fq * 8);
#define PG8_SA(b, h) (((b) * 2 + (h)) * HTB)
#define PG8_SB(b, h) ((4 + (b) * 2 + (h)) * HTB)
#define PG8_STAGE(bufoff, gbase, voff) do { _Pragma("unroll") for (int _i = 0; _i < 2; ++_i) { unsigned _vo = (voff)[_i]; asm volatile("" : "+v"(_vo));     \
        __builtin_amdgcn_global_load_lds((const unsigned*)((const char*)(gbase) + _vo), (PG8_LAS unsigned*)(lds + (bufoff) + ldsw + _i * 8192), 16, 0, 0); } } while (0)
#define PG8_STAGE_A(bufoff, gbase, h, sel) do { if constexpr (GATHER) { _Pragma("unroll") for (int _i = 0; _i < 2; ++_i) { unsigned _vo = cv[h][_i]; asm volatile("" : "+v"(_vo)); \
        __builtin_amdgcn_global_load_lds((const unsigned*)((const char*)(gbase) + _vo), (PG8_LAS unsigned*)(lds + (bufoff) + ldsw + _i * 8192), 16, 0, 0); } } \
        else PG8_STAGE(bufoff, (gbase) + (h) * hstep, voffA); } while (0)
#define PG8_LDA(dst, b, h) do { _Pragma("unroll") for (int m = 0; m < 4; ++m) { \
        if constexpr (FP8) dst##8[m] = __builtin_shufflevector(*(const PG8_LAS v4i_t*)(lds + PG8_SA(b, h) + aoff + m * 2048), *(const PG8_LAS v4i_t*)(lds + PG8_SA(b, h) + aoff + m * 2048 + 1024), 0, 1, 2, 3, 4, 5, 6, 7); \
        else { _Pragma("unroll") for (int k = 0; k < 2; ++k) dst[m][k] = *(const PG8_LAS bf16x8*)(lds + PG8_SA(b, h) + aoff + m * 2048 + k * 1024); } } } while (0)
#define PG8_LDB(dst, b, h) do { _Pragma("unroll") for (int n = 0; n < 2; ++n) { \
        if constexpr (FP8) dst##8[n] = __builtin_shufflevector(*(const PG8_LAS v4i_t*)(lds + PG8_SB(b, h) + boff + n * 2048), *(const PG8_LAS v4i_t*)(lds + PG8_SB(b, h) + boff + n * 2048 + 1024), 0, 1, 2, 3, 4, 5, 6, 7); \
        else { _Pragma("unroll") for (int k = 0; k < 2; ++k) dst[n][k] = *(const PG8_LAS bf16x8*)(lds + PG8_SB(b, h) + boff + n * 2048 + k * 1024); } } } while (0)
#define PG8_MMA(ai, bj, At, Bt) do { __builtin_amdgcn_s_setprio(1); _Pragma("unroll") for (int m = 0; m < 4; ++m) _Pragma("unroll") for (int n = 0; n < 2; ++n) { \
        if constexpr (FP8) acc[ai][bj][m][n] = __builtin_amdgcn_mfma_scale_f32_16x16x128_f8f6f4(Bt##8[n], At##8[m], acc[ai][bj][m][n], 0, 0, 0, 0x7f7f7f7f, 0, 0x7f7f7f7f); \
        else { _Pragma("unroll") for (int k = 0; k < 2; ++k) acc[ai][bj][m][n] = __builtin_amdgcn_mfma_f32_16x16x32_bf16(Bt[n][k], At[m][k], acc[ai][bj][m][n], 0, 0, 0); } } __builtin_amdgcn_s_setprio(0); } while (0)
#define PG8_WAIT_V(n) asm volatile("s_waitcnt vmcnt(" #n ")" ::: "memory")
#define PG8_WAIT_L(n) asm volatile("s_waitcnt lgkmcnt(" #n ")" ::: "memory")
#define PG8_BAR __builtin_amdgcn_s_barrier()
#define PG8_SCHED __builtin_amdgcn_sched_barrier(0)
    Unit cur, nxt; int ui = 0;
    if (!S.next(0, cur)) return;
    f32x4 acc[2][2][4][2];
#pragma unroll
    for (int a = 0; a < 2; ++a)
#pragma unroll
        for (int b = 0; b < 2; ++b)
#pragma unroll
            for (int m = 0; m < 4; ++m)
#pragma unroll
                for (int n = 0; n < 2; ++n) acc[a][b][m][n] = (f32x4){0.f, 0.f, 0.f, 0.f};
    bf16x8 At[4][2], B0[2][2], B1[2][2]; v8i_t At8[4], B08[2], B18[2];
    const char* cA = (const char*)g.A + (GATHER ? (size_t)0 : (size_t)cur.pm * tstep); const char* cB = (const char*)g.Bt + (size_t)cur.e * g.bstride + (size_t)cur.pn * tstep;
    S.a_ready(cur);
    PG8_ROWS(cv, 0);
    if constexpr (SP2) {
        PG8_STAGE(PG8_SB(0, 0), cB, voffB); PG8_STAGE(PG8_SB(0, 1), cB + hstep, voffB); PG8_STAGE_A(PG8_SA(0, 0), cA, 0, false); PG8_STAGE_A(PG8_SA(0, 1), cA, 1, false);
        if (wr == 1) PG8_BAR;
        PG8_WAIT_V(2); PG8_BAR;
        PG8_STAGE(PG8_SB(1, 0), cB + kstep, voffB); PG8_STAGE_A(PG8_SA(1, 0), cA + kstep, 0, false); PG8_STAGE(PG8_SB(1, 1), cB + hstep + kstep, voffB);
        PG8_WAIT_V(6); PG8_BAR;
    } else {
        PG8_STAGE(PG8_SB(0, 0), cB, voffB); PG8_STAGE_A(PG8_SA(0, 0), cA, 0, false); PG8_STAGE(PG8_SB(0, 1), cB + hstep, voffB); PG8_STAGE_A(PG8_SA(0, 1), cA, 1, false);
        if (wr == 1) PG8_BAR;
        PG8_WAIT_V(4); PG8_BAR;
        PG8_STAGE(PG8_SB(1, 0), cB + kstep, voffB); PG8_STAGE_A(PG8_SA(1, 0), cA + kstep, 0, false); PG8_STAGE(PG8_SB(1, 1), cB + hstep + kstep, voffB);
        PG8_WAIT_V(6); PG8_BAR;
    }
    for (;;) {
        const bool has_next = S.next(ui + 1, nxt);
        const char* nA = has_next ? (const char*)g.A + (GATHER ? (size_t)0 : (size_t)nxt.pm * tstep) : cA; const char* nB = has_next ? (const char*)g.Bt + (size_t)nxt.e * g.bstride + (size_t)nxt.pn * tstep : cB;
#pragma nounroll
        for (int t = 0; t < nt; t += 2) {
            const bool last = (t == nt - 2);
            const char* a1 = cA + (size_t)(t + 1) * kstep;
            const char* a2 = last ? nA : cA + (size_t)(t + 2) * kstep; const char* b2 = last ? nB : cB + (size_t)(t + 2) * kstep;
            const char* a3 = a2 + kstep; const char* b3 = b2 + kstep;
            if (last && has_next) S.a_ready(nxt);
            if constexpr (SP2) {
            PG8_LDB(B0, 0, 0); PG8_LDB(B1, 0, 1); PG8_SCHED; PG8_LDA(At, 0, 0); PG8_STAGE_A(PG8_SA(1, 1), a1, 1, false);
            if constexpr (GATHER) { if (last && has_next) PG8_ROWS(cv, ui + 1); }
            PG8_WAIT_V(8); PG8_WAIT_L(0); PG8_BAR; PG8_MMA(0, 0, At, B0); PG8_MMA(0, 1, At, B1); PG8_BAR; PG8_SCHED;
            PG8_LDA(At, 0, 1); PG8_STAGE(PG8_SB(0, 0), b2, voffB); PG8_STAGE(PG8_SB(0, 1), b2 + hstep, voffB); PG8_STAGE_A(PG8_SA(0, 0), a2, 0, last);
            PG8_WAIT_V(8); PG8_WAIT_L(0); PG8_BAR; PG8_MMA(1, 0, At, B0); PG8_MMA(1, 1, At, B1); PG8_BAR; PG8_SCHED;
            PG8_LDB(B0, 1, 0); PG8_LDB(B1, 1, 1); PG8_SCHED; PG8_LDA(At, 1, 0); PG8_STAGE_A(PG8_SA(0, 1), a2, 1, last);
            PG8_WAIT_V(8); PG8_WAIT_L(0); PG8_BAR; PG8_MMA(0, 0, At, B0); PG8_MMA(0, 1, At, B1); PG8_BAR; PG8_SCHED;
            PG8_LDA(At, 1, 1); PG8_STAGE(PG8_SB(1, 0), b3, voffB); PG8_STAGE(PG8_SB(1, 1), b3 + hstep, voffB); PG8_STAGE_A(PG8_SA(1, 0), a3, 0, last);
            PG8_WAIT_V(8); PG8_WAIT_L(0); PG8_BAR; PG8_MMA(1, 0, At, B0); PG8_MMA(1, 1, At, B1); PG8_BAR; PG8_SCHED;
            } else {
            PG8_LDB(B0, 0, 0); PG8_SCHED; PG8_LDA(At, 0, 0); PG8_STAGE_A(PG8_SA(1, 1), a1, 1, false);
            if constexpr (GATHER) { if (last && has_next) PG8_ROWS(cv, ui + 1); }
            PG8_WAIT_L(8); PG8_BAR; PG8_WAIT_L(0); PG8_MMA(0, 0, At, B0); PG8_BAR; PG8_SCHED;
            PG8_LDB(B1, 0, 1); PG8_STAGE(PG8_SB(0, 0), b2, voffB);
            PG8_BAR; PG8_WAIT_L(0); PG8_MMA(0, 1, At, B1); PG8_BAR;
            PG8_LDA(At, 0, 1); PG8_STAGE_A(PG8_SA(0, 0), a2, 0, last);
            PG8_BAR; PG8_WAIT_L(0); PG8_MMA(1, 0, At, B0); PG8_BAR; PG8_SCHED;
            PG8_STAGE(PG8_SB(0, 1), b2 + hstep, voffB);
            PG8_WAIT_V(6); PG8_BAR; PG8_MMA(1, 1, At, B1); PG8_BAR;
            PG8_LDB(B0, 1, 0); PG8_SCHED; PG8_LDA(At, 1, 0); PG8_STAGE_A(PG8_SA(0, 1), a2, 1, last);
            PG8_WAIT_L(8); PG8_BAR; PG8_WAIT_L(0); PG8_MMA(0, 0, At, B0); PG8_BAR; PG8_SCHED;
            PG8_LDB(B1, 1, 1); PG8_STAGE(PG8_SB(1, 0), b3, voffB);
            PG8_BAR; PG8_WAIT_L(0); PG8_MMA(0, 1, At, B1); PG8_BAR;
            PG8_LDA(At, 1, 1); PG8_STAGE_A(PG8_SA(1, 0), a3, 0, last);
            PG8_BAR; PG8_WAIT_L(0); PG8_MMA(1, 0, At, B0); PG8_BAR; PG8_SCHED;
            PG8_STAGE(PG8_SB(1, 1), b3 + hstep, voffB);
            PG8_WAIT_V(6); PG8_BAR; PG8_MMA(1, 1, At, B1); PG8_BAR;
            }
        }
        if constexpr (ALIGN_EPI) { if (wr == 0) PG8_BAR; }
        if constexpr (!Epi::AFTER_DRAIN) { int tz_ = threadIdx.x; asm volatile("" : "+v"(tz_));
            const int l2_ = tz_ & 63; E(acc, cur, wr, wc, l2_ & 15, l2_ >> 4); S.done(cur); }
        if (!has_next) break;
#pragma unroll
        for (int a = 0; a < 2; ++a)
#pragma unroll
            for (int b = 0; b < 2; ++b)
#pragma unroll
                for (int m = 0; m < 4; ++m)
#pragma unroll
                    for (int n = 0; n < 2; ++n) acc[a][b][m][n] = (f32x4){0.f, 0.f, 0.f, 0.f};
        cur = nxt; cA = nA; cB = nB; ++ui;
        if constexpr (ALIGN_EPI) { if (wr == 1) PG8_BAR; }
    }
    PG8_WAIT_V(0);
    if constexpr (!ALIGN_EPI) { if (wr == 0) PG8_BAR; }
    PG8_BAR;
    if constexpr (Epi::AFTER_DRAIN) { E.fused(acc, cur, wr, wc, fr, fq, lds, wid, lane); S.done(cur); }
#undef PG8_SA
#undef PG8_SB
#undef PG8_STAGE
#undef PG8_STAGE_A
#undef PG8_ROWS
#undef PG8_LDA
#undef PG8_LDB
#undef PG8_MMA
#undef PG8_WAIT_V
#undef PG8_WAIT_L
#undef PG8_BAR
#undef PG8_SCHED
}
}

constexpr int DM = 2048, NB = 4, SEQ = 4096, T = NB * SEQ, CL = 256, TC = NB * CL, TA = T + TC;
constexpr int NPRJ = 4608;
constexpr int C_QA = 0, C_KA = 1024, C_VA = 1280, C_QB = 1536, C_KB = 2048, C_VB = 2560, C_RB = 3584, C_GB = 4608, INW = 4640;
constexpr int NE = 32, EH = 1024, NMOD = 6 * DM;
constexpr float ALPHA = 1.189207115002721f, LN_EPS = 1e-6f;
constexpr int MOE_MAXUNITS = 12;
constexpr int MAXTILES = 160;

constexpr size_t MiB = 1u << 20;
constexpr size_t WS_CTL = 0, CTL_ZERO_BYTES = 1 * MiB;
constexpr size_t WS_MODP = 1 * MiB;
constexpr size_t WS_WQH = 1 * MiB, WS_WQL = 2 * MiB, WS_UV = 3 * MiB;
constexpr size_t WS_MOD = 9 * MiB;
constexpr size_t WS_ROPE = 9 * MiB + 256 * 1024;
constexpr size_t WS_WG = 9 * MiB + 896 * 1024;
constexpr size_t WS_TOK = 10 * MiB;
constexpr size_t TOK_E = WS_TOK, TOK_RANK = WS_TOK + 131072, TOK_W = WS_TOK + 262144, TOK_SLOT = WS_TOK + 393216, TOK_CNT = WS_TOK + 524288, TOK_META = WS_TOK + 557056, TOK_ROWST = WS_TOK + 655360, TOK_PERM = WS_TOK + 786432;
constexpr size_t WS_GB = 11 * MiB;
constexpr size_t WS_WIN = 14 * MiB, WS_WINR = 22 * MiB;
constexpr size_t WS_WOUT = 32 * MiB;
constexpr size_t WS_WGU = 40 * MiB;
constexpr size_t WS_WDN = 296 * MiB;
constexpr size_t WS_R1 = 424 * MiB;
constexpr size_t WS_R2 = 584 * MiB;
constexpr size_t WS_H8 = WS_R2 + 70 * MiB;
constexpr size_t WS_MIX = 712 * MiB;
constexpr size_t WS_GL = 860 * MiB;
constexpr size_t WS_GLD = 792 * MiB;
constexpr size_t WS_X1 = 794 * MiB;
constexpr size_t WS_END = 922 * MiB;
constexpr int CW_TMO = 0, CW_BAR = 4096, CW_GEMV = 8192;

constexpr int RING_BYTES = 131072, MISC_OFF = RING_BYTES, TILE_OFF = RING_BYTES + 256, LDS_BYTES = 147456;

#define GAS __attribute__((address_space(1)))
#define LAS __attribute__((address_space(3)))
typedef unsigned short bf16;
typedef unsigned v4u __attribute__((ext_vector_type(4)));
typedef unsigned v2u __attribute__((ext_vector_type(2)));
typedef float f32x4 __attribute__((ext_vector_type(4)));
typedef float f32x2 __attribute__((ext_vector_type(2)));
typedef short bf16x8 __attribute__((ext_vector_type(8)));
typedef short bf16x4 __attribute__((ext_vector_type(4)));
#define LDS_WAIT() asm volatile("s_waitcnt lgkmcnt(0)" ::: "memory")
#define VM_WAIT() asm volatile("s_waitcnt vmcnt(0)" ::: "memory")
typedef __bf16 bf16v2_t __attribute__((ext_vector_type(2)));
__device__ __forceinline__ unsigned f2bf(float f) { return (unsigned)__builtin_bit_cast(unsigned short, (__bf16)f); }
__device__ __forceinline__ unsigned pk2(float lo, float hi) { bf16v2_t v = {(__bf16)lo, (__bf16)hi}; return __builtin_bit_cast(unsigned, v); }
__device__ __forceinline__ float clamp_fp8(float v) { return __builtin_amdgcn_fmed3f(v, -448.f, 448.f); }
__device__ __forceinline__ unsigned pk4_fp8(float a, float b, float c, float d) {
    int w = 0; w = __builtin_amdgcn_cvt_pk_fp8_f32(clamp_fp8(a), clamp_fp8(b), w, false); w = __builtin_amdgcn_cvt_pk_fp8_f32(clamp_fp8(c), clamp_fp8(d), w, true); return (unsigned)w; }
constexpr float W8_SCALE = 64.f, W8_INV = 1.f / 64.f;
__device__ __forceinline__ float bf2f(unsigned h) { return __builtin_bit_cast(float, h << 16); }
__device__ __forceinline__ float wave_sum(float v) {
#pragma unroll
    for (int o = 1; o < 64; o <<= 1) v += __shfl_xor(v, o);
    return v;
}
__device__ __forceinline__ float silu_f(float v) { return v * __builtin_amdgcn_rcpf(1.f + __builtin_amdgcn_exp2f(v * -1.4426950408889634f)); }

#define XB_TMO      128
#define XB_XCNT(j)  (256  + 64 * (j))
#define XB_XSUB(j)  (1280 + 64 * (j))
#define XB_XGEN(j)  (2304 + 64 * (j))
#define XB_TOP      3328
#define XB_TOPGEN   3392
#define XCD_BAR_WORDS 3456
#define XB_SPIN_CAP (1u << 18)
__device__ __forceinline__ unsigned xb_ld(unsigned* p)              { return __hip_atomic_load(p, __ATOMIC_RELAXED, __HIP_MEMORY_SCOPE_AGENT); }
__device__ __forceinline__ unsigned xb_add(unsigned* p, unsigned v) { return __hip_atomic_fetch_add(p, v, __ATOMIC_RELAXED, __HIP_MEMORY_SCOPE_AGENT); }
__device__ __forceinline__ unsigned xb_xcc_id() { return (unsigned)__builtin_amdgcn_s_getreg((3 << 11) | 20) & 0xFu; }
#define XB_SPIN(cond, bar) do { unsigned _sp = 0; while (cond) { __builtin_amdgcn_s_sleep(1); \
    if ((++_sp & 255u) == 0u) { if (xb_ld(&(bar)[XB_TMO])) break; if (_sp > XB_SPIN_CAP) { atomicAdd(&(bar)[XB_TMO], 1u); break; } } } } while (0)
struct XcdBarrier { unsigned* bar; unsigned x; volatile LAS unsigned* st; };
__device__ __forceinline__ XcdBarrier xcd_barrier_post(unsigned* bar, volatile LAS unsigned* st) {
    XcdBarrier b; b.bar = bar; b.x = xb_xcc_id(); b.st = st;
    if (threadIdx.x == 0) (void)xb_add(&bar[XB_XCNT(b.x)], 1u);
    return b;
}
__device__ __forceinline__ void xcd_barrier_complete(unsigned* bar, unsigned x, unsigned& nloc, unsigned& nx) {
    const unsigned G = gridDim.x * gridDim.y * gridDim.z;
    unsigned sum, cnt, mine, sp = 0u;
    for (;;) {
        sum = 0u; cnt = 0u; mine = 0u;
#pragma unroll
        for (unsigned j = 0; j < 16; ++j) { const unsigned c = xb_ld(&bar[XB_XCNT(j)]); sum += c; cnt += (c > 0u) ? 1u : 0u; mine = (j == x) ? c : mine; }
        if (sum == G) break;
        __builtin_amdgcn_s_sleep(1);
        if ((++sp & 255u) == 0u) { if (xb_ld(&bar[XB_TMO])) break; if (sp > XB_SPIN_CAP) { atomicAdd(&bar[XB_TMO], 1u); break; } }
    }
    nloc = mine > 0u ? mine : 1u; nx = cnt > 0u ? cnt : 1u;
}
__device__ __forceinline__ void xcd_barrier(const XcdBarrier& b) {
    asm volatile("s_waitcnt vmcnt(0)" ::: "memory");
    __syncthreads();
    if (threadIdx.x == 0) {
        unsigned* bar = b.bar;
        __builtin_amdgcn_s_waitcnt(0);
        unsigned nloc = b.st[0], nx = b.st[1];
        if (nloc == 0u) { xcd_barrier_complete(bar, b.x, nloc, nx); b.st[0] = nloc; b.st[1] = nx; }
        const unsigned old = xb_add(&bar[XB_XSUB(b.x)], 1u);
        const unsigned gen = old / nloc;
        if (old + 1u == (gen + 1u) * nloc) {
            __builtin_amdgcn_fence(__ATOMIC_RELEASE, "agent");
            asm volatile("s_waitcnt vmcnt(0)" ::: "memory");
            const unsigned og = xb_add(&bar[XB_TOP], 1u);
            const unsigned tg = og / nx;
            if (og + 1u == (tg + 1u) * nx) xb_add(&bar[XB_TOPGEN], 1u);
            else XB_SPIN(xb_ld(&bar[XB_TOPGEN]) == tg, bar);
            __builtin_amdgcn_fence(__ATOMIC_ACQUIRE, "agent");
            xb_add(&bar[XB_XGEN(b.x)], 1u);
            asm volatile("s_waitcnt vmcnt(0)" ::: "memory");
        } else {
            XB_SPIN(xb_ld(&bar[XB_XGEN(b.x)]) == gen, bar);
            __builtin_amdgcn_fence(__ATOMIC_ACQUIRE, "agent");
            asm volatile("s_waitcnt vmcnt(0)" ::: "memory");
        }
    }
    __syncthreads();
}

struct Ctx {
    LAS unsigned char* lds;
    int tid, lane, wave, G;
    const float *x, *c, *ctx, *c_ctx, *w_ada, *b_ada, *w_in, *w_gate_up, *b_gate, *attn_sink, *gla_norm_w, *w_out, *ln1_g, *ln1_b,
                *w_rg, *b_rg, *w_re, *b_re, *w_eg, *w_eu, *w_ed, *ln2_g, *ln2_b;
    float* out; unsigned char* ws;
};
#define WSP(T_, off) ((T_*)(F.ws + (off)))

template <class SrcCol>
__device__ __forceinline__ void transpose_item(const SrcCol& sc, size_t ldw, int K, bf16* WT, int n0, int k0, LAS float* scr, int lane) {
    const float* colp = sc(n0 + (lane & 31));
    float v[32];
#pragma unroll
    for (int i = 0; i < 32; ++i) v[i] = *(const GAS float*)(colp + (size_t)(k0 + 2 * i + (lane >> 5)) * ldw);
#pragma unroll
    for (int i = 0; i < 32; ++i) scr[(2 * i + (lane >> 5)) * 33 + (lane & 31)] = v[i];
    LDS_WAIT(); asm volatile("" ::: "memory");
    const int c = lane & 7;
#pragma unroll
    for (int j = 0; j < 4; ++j) { const int n = (lane >> 3) + 8 * j; const LAS float* s = scr + (8 * c) * 33 + n;
        v4u o; o.x = pk2(s[0 * 33], s[1 * 33]); o.y = pk2(s[2 * 33], s[3 * 33]); o.z = pk2(s[4 * 33], s[5 * 33]); o.w = pk2(s[6 * 33], s[7 * 33]);
        *(GAS v4u*)(WT + (size_t)(n0 + n) * K + k0 + 8 * c) = o; }
    LDS_WAIT(); asm volatile("" ::: "memory");
}
template <class SrcCol>
__device__ __forceinline__ void transpose_item_fp8(const SrcCol& sc, size_t ldw, int K, unsigned char* WT, int n0, int k0, LAS float* scr, int lane) {
    const float* colp = sc(n0 + (lane & 31));
    float v[32];
#pragma unroll
    for (int i = 0; i < 32; ++i) v[i] = *(const GAS float*)(colp + (size_t)(k0 + 2 * i + (lane >> 5)) * ldw);
#pragma unroll
    for (int i = 0; i < 32; ++i) scr[(2 * i + (lane >> 5)) * 33 + (lane & 31)] = v[i] * W8_SCALE;
    LDS_WAIT(); asm volatile("" ::: "memory");
    const int c = lane & 7;
#pragma unroll
    for (int j = 0; j < 4; ++j) { const int n = (lane >> 3) + 8 * j; const LAS float* s = scr + (8 * c) * 33 + n;
        v2u o; o.x = pk4_fp8(s[0 * 33], s[1 * 33], s[2 * 33], s[3 * 33]); o.y = pk4_fp8(s[4 * 33], s[5 * 33], s[6 * 33], s[7 * 33]);
        *(GAS v2u*)(WT + (size_t)(n0 + n) * K + k0 + 8 * c) = o; }
    LDS_WAIT(); asm volatile("" ::: "memory");
}
__device__ __forceinline__ int rope_sigma(int p) { const int q = (p >> 3) * 4 + (p & 3), n = (p >> 2) & 1; return (q >> 5) * 64 + n * 32 + (q & 31); }
struct SrcWin { const float* w; __device__ __forceinline__ const float* operator()(int j) const { int col = j; if (j < C_VA) col = (j & ~127) + rope_sigma(j & 127); return w + col; } };
struct SrcPlain { const float* w; __device__ __forceinline__ const float* operator()(int j) const { return w + j; } };
struct SrcGU { const float* wg; long long du; __device__ __forceinline__ const float* operator()(int j) const { const int pn = j >> 8, jj = j & 127; return wg + (long long)((j >> 7) & 1) * du + pn * 128 + jj; } };

constexpr int XP_ITEMS = NE * 192, XP_N3 = 0, XP_N4 = 0,
    XP_N0 = XP_ITEMS - XP_N3 - XP_N4;
__device__ __forceinline__ void xp_convert(Ctx& F, int it_begin, int it_end, int rank, int nranks) {
    const int tid = threadIdx.x;
    LAS float* tl = (LAS float*)F.lds;
    const long long off_up = (long long)(F.w_eu - F.w_eg), off_dn = (long long)(F.w_ed - F.w_eg);
#define XP_SRC(it_, W_, ldw_, k0_, c0_, kind_) const int e_##W_ = (it_) / 192, q_##W_ = (it_) % 192, kind_ = q_##W_ >> 6, r_##W_ = q_##W_ & 63; \
        const float* W_ = F.w_eg + ((kind_ == 0 ? 0ll : kind_ == 1 ? off_up : off_dn) + (long long)e_##W_ * DM * EH); \
        const size_t ldw_ = kind_ < 2 ? EH : DM; const int k0_ = kind_ < 2 ? (r_##W_ >> 2) * 128 : (r_##W_ >> 3) * 128, c0_ = kind_ < 2 ? (r_##W_ & 3) * 256 : (r_##W_ & 7) * 256;
    f32x4 v[16];
    if (it_begin + rank < it_end) { XP_SRC(it_begin + rank, W, ldw, k0, c0, kind); (void)kind;
#pragma unroll
        for (int i = 0; i < 16; ++i) v[i] = *(const GAS f32x4*)(W + (size_t)(k0 + (tid >> 6) + 8 * i) * ldw + c0 + 4 * (tid & 63)); }
    for (int it = it_begin + rank; it < it_end; it += nranks) {
        XP_SRC(it, Wc, ldwc, k0, c0, kind); (void)Wc; (void)ldwc;
        const int e = it / 192;
        const int Kb = kind < 2 ? DM : EH;
        unsigned char* D = F.ws + (kind < 2 ? WS_WGU + (size_t)e * DM * DM : WS_WDN + (size_t)e * DM * EH);
        __syncthreads();
#pragma unroll
        for (int i = 0; i < 16; ++i) *(LAS f32x4*)(tl + ((tid >> 6) + 8 * i) * 256 + 4 * (tid & 63)) = v[i] * W8_SCALE;
        __syncthreads();
        if (it + nranks < it_end) { XP_SRC(it + nranks, W2, ldw2, k02, c02, kind2); (void)kind2;
#pragma unroll
            for (int i = 0; i < 16; ++i) v[i] = *(const GAS f32x4*)(W2 + (size_t)(k02 + (tid >> 6) + 8 * i) * ldw2 + c02 + 4 * (tid & 63)); }
        const int nl = tid & 255, kh = tid >> 8;
        const int c = c0 + nl;
        const int drow = kind < 2 ? ((c >> 7) * 256 + kind * 128 + (c & 127)) : c;
        unsigned char* dp = D + (size_t)drow * Kb + k0 + 64 * kh;
        const LAS float* tc = tl + (64 * kh) * 256 + nl;
#pragma unroll
        for (int j = 0; j < 4; ++j) { v4u o;
            o.x = pk4_fp8(tc[(16 * j + 0) * 256], tc[(16 * j + 1) * 256], tc[(16 * j + 2) * 256], tc[(16 * j + 3) * 256]);
            o.y = pk4_fp8(tc[(16 * j + 4) * 256], tc[(16 * j + 5) * 256], tc[(16 * j + 6) * 256], tc[(16 * j + 7) * 256]);
            o.z = pk4_fp8(tc[(16 * j + 8) * 256], tc[(16 * j + 9) * 256], tc[(16 * j + 10) * 256], tc[(16 * j + 11) * 256]);
            o.w = pk4_fp8(tc[(16 * j + 12) * 256], tc[(16 * j + 13) * 256], tc[(16 * j + 14) * 256], tc[(16 * j + 15) * 256]);
            *(GAS v4u*)(dp + 16 * j) = o; }
    }
#undef XP_SRC
    __syncthreads();
}

__device__ __forceinline__ void p0_prologue(Ctx& F) {
    const int tid = F.tid, lane = F.lane, wave = F.wave, G = F.G;
    {
        LAS float* sil = (LAS float*)(F.lds);
        LAS float* red = (LAS float*)(F.lds + 40960);
        for (int i = tid; i < 5 * DM; i += 512) { const int r = i >> 11, k = i & 2047; const float v = r < 4 ? F.c[r * DM + k] : F.c_ctx[k]; sil[i] = silu_f(v); }
        __syncthreads();
        const int c4 = tid & 127, ks = tid >> 7;
        float* MODP = WSP(float, WS_MODP);
        for (int u = blockIdx.x; u < 768; u += G) {
            const int cg = u % 24, ksl = u / 24, col = cg * 512 + c4 * 4, k0 = ksl * 64 + ks * 16;
            f32x4 acc[5];
#pragma unroll
            for (int r = 0; r < 5; ++r) acc[r] = (f32x4){0.f, 0.f, 0.f, 0.f};
            f32x4 w[16];
#pragma unroll
            for (int i = 0; i < 16; ++i) w[i] = *(const GAS f32x4*)(F.w_ada + (size_t)(k0 + i) * NMOD + col);
#pragma unroll
            for (int i = 0; i < 16; ++i)
#pragma unroll
                for (int r = 0; r < 5; ++r) acc[r] += sil[r * DM + k0 + i] * w[i];
#pragma unroll
            for (int r = 0; r < 5; ++r) *(LAS f32x4*)(red + (ks * 5 + r) * 512 + c4 * 4) = acc[r];
            __syncthreads();
            for (int o = tid; o < 2560; o += 512) { const int r = o >> 9, cc = o & 511;
                MODP[(size_t)(ksl * 5 + r) * NMOD + cg * 512 + cc] = (red[(0 * 5 + r) * 512 + cc] + red[(1 * 5 + r) * 512 + cc]) + (red[(2 * 5 + r) * 512 + cc] + red[(3 * 5 + r) * 512 + cc]); }
            __syncthreads();
        }
    }
    {
        const int gt = blockIdx.x * 512 + tid, NT = G * 512;
        float* rc = WSP(float, WS_ROPE); float* rs = rc + 2048;
        for (int i = gt; i < 2048; i += NT) { const int pos = i >> 5, f = i & 31; const float inv = powf(10000.0f, -(float)f / 32.0f), ang = (float)pos * inv; rc[i] = cosf(ang); rs[i] = sinf(ang); }
    }
    xp_convert(F, 0, F.G == 256 ? XP_N0 : XP_ITEMS, (int)blockIdx.x, G);
#ifdef PROBE_XP
    xp_convert(F, 0, F.G == 256 ? XP_N0 : XP_ITEMS, (int)blockIdx.x, G);
#endif
    {
        LAS float* scr = (LAS float*)(F.lds + wave * 8448);
        const int gw = blockIdx.x * 8 + wave, NGW = G * 8;
        constexpr int I_WIN = 144 * 32, I_WG = 32, I_WOUT = 64 * 32;
        constexpr int NITEMS = I_WIN + I_WG + I_WOUT;
        for (int it = gw; it < NITEMS; it += NGW) {
            int r = it;
            if (r < I_WIN) { SrcWin s{F.w_in}; const int n0 = (r >> 5) * 32, k0 = (r & 31) * 64;
                if (n0 < C_RB) transpose_item_fp8(s, INW, DM, WSP(unsigned char, WS_WIN), n0, k0, scr, lane);
                else { SrcPlain s2{F.w_in + C_RB}; transpose_item(s2, INW, DM, WSP(bf16, WS_WINR), n0 - C_RB, k0, scr, lane); }
                continue; } r -= I_WIN;
            if (r < I_WG) { SrcPlain s{F.w_in + C_GB}; transpose_item(s, INW, DM, WSP(bf16, WS_WG), 0, r * 64, scr, lane); continue; } r -= I_WG;
            { SrcPlain s{F.w_out}; transpose_item_fp8(s, DM, DM, WSP(unsigned char, WS_WOUT), (r >> 5) * 32, (r & 31) * 64, scr, lane); }
        }
    }
}
__device__ __forceinline__ void p1_modreduce(Ctx& F) {
    const float* MODP = WSP(float, WS_MODP); float* MOD = WSP(float, WS_MOD);
    for (int i = blockIdx.x * 512 + F.tid; i < 5 * NMOD; i += F.G * 512) { const int n = i % NMOD; float s = F.b_ada[n];
#pragma unroll 8
        for (int k = 0; k < 32; ++k) s += MODP[(size_t)k * 5 * NMOD + i];
        MOD[i] = s; }
}
__device__ __forceinline__ void p2_router_tables(Ctx& F) {
    const float* MOD = WSP(float, WS_MOD); bf16* WQH = WSP(bf16, WS_WQH); bf16* WQL = WSP(bf16, WS_WQL); float* UV = WSP(float, WS_UV);
    for (int i4 = blockIdx.x * 512 + F.tid; i4 < 4 * 48 * DM / 4; i4 += F.G * 512) { const int i = 4 * i4, b = i / (48 * DM), j = (i >> 11) % 48, k = i & 2047;
        const f32x4 g4 = *(const GAS f32x4*)(F.ln1_g + k), s4 = *(const GAS f32x4*)(MOD + (size_t)b * NMOD + 4 * DM + k); f32x4 w4 = {0.f, 0.f, 0.f, 0.f};
#pragma unroll
        for (int e = 0; e < 4; ++e) { if (j < 4) w4[e] = F.w_rg[(k + e) * 4 + j]; else if (j < 36) w4[e] = F.w_re[(k + e) * 32 + (j - 4)]; }
        const f32x4 wq = w4 * g4 * (s4 + 1.f);
        const unsigned h0 = f2bf(wq[0]), h1 = f2bf(wq[1]), h2 = f2bf(wq[2]), h3 = f2bf(wq[3]);
        v2u oh, ol; oh.x = h0 | (h1 << 16); oh.y = h2 | (h3 << 16); ol.x = pk2(wq[0] - bf2f(h0), wq[1] - bf2f(h1)); ol.y = pk2(wq[2] - bf2f(h2), wq[3] - bf2f(h3));
        *(GAS v2u*)(WQH + i) = oh; *(GAS v2u*)(WQL + i) = ol; }
    if (F.wave == 0) for (int pr = blockIdx.x; pr < 4 * 48; pr += F.G) { const int b = pr / 48, j = pr % 48; const float* mr = MOD + (size_t)b * NMOD; float u0 = 0.f, u1 = 0.f, u2 = 0.f, u3 = 0.f;
        f32x4 g4[8], b4[8], s4[8], h4[8], w4[8];
#pragma unroll
        for (int i = 0; i < 8; ++i) { const int k = 4 * F.lane + 256 * i; g4[i] = *(const GAS f32x4*)(F.ln1_g + k); b4[i] = *(const GAS f32x4*)(F.ln1_b + k); s4[i] = *(const GAS f32x4*)(mr + 4 * DM + k); h4[i] = *(const GAS f32x4*)(mr + 3 * DM + k);
            w4[i] = (f32x4){0.f, 0.f, 0.f, 0.f};
#pragma unroll
            for (int e = 0; e < 4; ++e) { if (j < 4) w4[i][e] = F.w_rg[(k + e) * 4 + j]; else if (j < 36) w4[i][e] = F.w_re[(k + e) * 32 + (j - 4)]; } }
#pragma unroll
        for (int i = 0; i < 8; ++i)
#pragma unroll
            for (int e = 0; e < 4; ++e) { const float w = w4[i][e], sc = 1.f + s4[i][e], wq = w * g4[i][e] * sc; const float hi = bf2f(f2bf(wq)), lo = bf2f(f2bf(wq - hi));
                u0 += hi + lo; u1 += b4[i][e] * sc * w; u2 += sc * w; u3 += h4[i][e] * w; }
        u0 = wave_sum(u0); u1 = wave_sum(u1); u2 = wave_sum(u2); u3 = wave_sum(u3) + (j < 4 ? F.b_rg[j] : j < 36 ? F.b_re[j - 4] : 0.f);
        if (F.lane == 0) { UV[(b * 4 + 0) * 48 + j] = u0; UV[(b * 4 + 1) * 48 + j] = u1; UV[(b * 4 + 2) * 48 + j] = u2; UV[(b * 4 + 3) * 48 + j] = u3; } }
}
__device__ __forceinline__ void p2_modulate(Ctx& F) {
    const float* MOD = WSP(float, WS_MOD); bf16* H = WSP(bf16, WS_R2); unsigned char* H8 = WSP(unsigned char, WS_H8);
    const int gw = blockIdx.x * 8 + F.wave, NGW = F.G * 8, lane = F.lane;
    f32x4 nx[8];
    if (gw < TA) { const float* src = gw < T ? F.x + (size_t)gw * DM : F.ctx + (size_t)(gw - T) * DM;
#pragma unroll
        for (int j = 0; j < 8; ++j) nx[j] = *(const GAS f32x4*)(src + 4 * lane + 256 * j); }
    for (int row = gw; row < TA; row += NGW) {
        const float* mr = MOD + (size_t)(row < T ? (row >> 12) : 4) * NMOD;
        f32x4 v[8], sh[8], sc[8]; float s = 0.f;
#pragma unroll
        for (int j = 0; j < 8; ++j) { v[j] = nx[j]; sh[j] = *(const GAS f32x4*)(mr + 4 * lane + 256 * j); sc[j] = *(const GAS f32x4*)(mr + DM + 4 * lane + 256 * j); }
        const int nrow = row + NGW;
        if (nrow < TA) { const float* src = nrow < T ? F.x + (size_t)nrow * DM : F.ctx + (size_t)(nrow - T) * DM;
#pragma unroll
            for (int j = 0; j < 8; ++j) nx[j] = *(const GAS f32x4*)(src + 4 * lane + 256 * j); }
#pragma unroll
        for (int j = 0; j < 8; ++j) s += (v[j].x + v[j].y) + (v[j].z + v[j].w);
        const float mean = wave_sum(s) * (1.f / DM); float s2 = 0.f;
#pragma unroll
        for (int j = 0; j < 8; ++j) { v[j] = v[j] - mean; s2 += (v[j].x * v[j].x + v[j].y * v[j].y) + (v[j].z * v[j].z + v[j].w * v[j].w); }
        const float rstd = 1.f / sqrtf(wave_sum(s2) * (1.f / DM) + LN_EPS);
#pragma unroll
        for (int j = 0; j < 8; ++j) { const f32x4 h = v[j] * rstd * (sc[j] + 1.f) + sh[j]; v2u o; o.x = pk2(h.x, h.y); o.y = pk2(h.z, h.w);
            *(GAS v2u*)(H + (size_t)row * DM + 4 * lane + 256 * j) = o;
            *(GAS unsigned*)(H8 + (size_t)row * DM + 4 * lane + 256 * j) = pk4_fp8(h.x, h.y, h.z, h.w); }
    }
}


__device__ __forceinline__ void p3_gate(Ctx& F) {
    const bf16* H = WSP(bf16, WS_R2); const bf16* WG = WSP(bf16, WS_WG); bf16* GBp = WSP(bf16, WS_GB);
    const int tid = F.tid, c16 = F.lane & 15, g16 = F.lane >> 4;
    LAS unsigned char* wl = F.lds;
#pragma unroll
    for (int i = 0; i < 16; ++i) { const int cid = tid + 512 * i, n = cid >> 8, c = cid & 255;
        *(LAS v4u*)(wl + n * 4096 + ((c ^ (n & 15)) << 4)) = *(const GAS v4u*)(WG + (size_t)n * DM + c * 8); }
    __syncthreads();
    const int rt = (int)blockIdx.x + F.G * F.wave;
    if (rt < TA / 16) {
        const bf16* ap = H + (size_t)(rt * 16 + c16) * DM + 8 * g16;
        f32x4 a0 = {0.f, 0.f, 0.f, 0.f}, a1 = a0;
        for (int bt = 0; bt < 4; ++bt) {
            bf16x8 av[16];
#pragma unroll
            for (int q = 0; q < 16; ++q) av[q] = *(const GAS bf16x8*)(ap + 32 * (16 * bt + q));
#pragma unroll
            for (int q = 0; q < 16; ++q) { const int ch = ((4 * (16 * bt + q) + g16) ^ c16) << 4;
                const bf16x8 b0 = *(const LAS bf16x8*)(wl + c16 * 4096 + ch), b1 = *(const LAS bf16x8*)(wl + (16 + c16) * 4096 + ch);
                a0 = __builtin_amdgcn_mfma_f32_16x16x32_bf16(av[q], b0, a0, 0, 0, 0); a1 = __builtin_amdgcn_mfma_f32_16x16x32_bf16(av[q], b1, a1, 0, 0, 0); }
        }
#pragma unroll
        for (int r = 0; r < 4; ++r) { bf16* o = GBp + (size_t)(rt * 16 + 4 * g16 + r) * 32 + c16; o[0] = (bf16)f2bf(a0[r]); o[16] = (bf16)f2bf(a1[r]); }
    }
    __syncthreads();
}
struct EpiProj {
    static constexpr bool PERM = true, AFTER_DRAIN = false;
    bf16* O; const float* rope; float sc;
    __device__ __forceinline__ void operator()(const f32x4 (&acc)[2][2][4][2], const pg8::Unit& u, int wr, int wc, int fr, int fq) const {
        const int row0 = u.pm * 256 + wr * 64 + fr, col0 = u.pn * 256 + wc * 32 + 8 * fq;
        const bool rot = (u.pn < 5) && (u.pm < 64);
        const int fo = (4 * (wc & 1) + fq) * 4;
        f32x4 cs[2][4], sn[2][4];
#pragma unroll
        for (int ai = 0; ai < 2; ++ai)
#pragma unroll
            for (int m = 0; m < 4; ++m) { cs[ai][m] = (f32x4){1.f, 1.f, 1.f, 1.f}; sn[ai][m] = (f32x4){0.f, 0.f, 0.f, 0.f};
                if (rot) { const int s = (row0 + ai * 128 + m * 16) & (SEQ - 1), pos = (wc >> 1) ? (s & 63) : (s >> 6); cs[ai][m] = *(const GAS f32x4*)(rope + pos * 32 + fo); sn[ai][m] = *(const GAS f32x4*)(rope + 2048 + pos * 32 + fo); } }
#pragma unroll
        for (int ai = 0; ai < 2; ++ai)
#pragma unroll
            for (int m = 0; m < 4; ++m) {
                bf16* rowp = O + (size_t)(row0 + ai * 128 + m * 16) * NPRJ + col0;
#pragma unroll
                for (int bj = 0; bj < 2; ++bj) {
                    const f32x4 t1 = acc[ai][bj][m][0] * sc, t2 = acc[ai][bj][m][1] * sc;
                    const f32x4 v0 = t1 * cs[ai][m] - t2 * sn[ai][m], v1 = t2 * cs[ai][m] + t1 * sn[ai][m];
                    v4u w; w.x = pk2(v0[0], v0[1]); w.y = pk2(v0[2], v0[3]); w.z = pk2(v1[0], v1[1]); w.w = pk2(v1[2], v1[3]);
                    *(GAS v4u*)(rowp + bj * 128) = w; }
            }
    }
};

struct EpiCols {
    static constexpr bool PERM = true, AFTER_DRAIN = false;
    bf16* O; int ldc, c0;
    __device__ __forceinline__ void operator()(const f32x4 (&acc)[2][2][4][2], const pg8::Unit& u, int wr, int wc, int fr, int fq) const {
        const int row0 = u.pm * 256 + wr * 64 + fr, col0 = c0 + u.pn * 256 + wc * 32 + 8 * fq;
#pragma unroll
        for (int ai = 0; ai < 2; ++ai)
#pragma unroll
            for (int m = 0; m < 4; ++m) { bf16* rowp = O + (size_t)(row0 + ai * 128 + m * 16) * ldc + col0;
#pragma unroll
                for (int bj = 0; bj < 2; ++bj) { const f32x4 v0 = acc[ai][bj][m][0], v1 = acc[ai][bj][m][1];
                    v4u w; w.x = pk2(v0[0], v0[1]); w.y = pk2(v0[2], v0[3]); w.z = pk2(v1[0], v1[1]); w.w = pk2(v1[2], v1[3]); *(GAS v4u*)(rowp + bj * 128) = w; } }
    }
};
__device__ __forceinline__ v2u tr_rd(unsigned a) { v2u r; asm volatile("ds_read_b64_tr_b16 %0, %1" : "=&v"(r) : "v"(a) : "memory"); return r; }
template <int OFF> __device__ __forceinline__ v2u tr_rdo(unsigned a) { v2u r; asm volatile("ds_read_b64_tr_b16 %0, %1 offset:%2" : "=&v"(r) : "v"(a), "i"(OFF) : "memory"); return r; }
#define TR_ROW4(L, H, base, K) do { L[0] = tr_rdo<(K) * 9216>(base); H[0] = tr_rdo<(K) * 9216 + 4608>(base); L[1] = tr_rdo<(K) * 9216 + 32>(base); H[1] = tr_rdo<(K) * 9216 + 32 + 4608>(base); \
        L[2] = tr_rdo<(K) * 9216 + 64>(base); H[2] = tr_rdo<(K) * 9216 + 64 + 4608>(base); L[3] = tr_rdo<(K) * 9216 + 96>(base); H[3] = tr_rdo<(K) * 9216 + 96 + 4608>(base); } while (0)
#define TR_ROW2(L, H, base, K) do { L[0] = tr_rdo<(K) * 9216>(base); H[0] = tr_rdo<(K) * 9216 + 4608>(base); L[1] = tr_rdo<(K) * 9216 + 32>(base); H[1] = tr_rdo<(K) * 9216 + 32 + 4608>(base); } while (0)
#define LDS_BARRIER() do { asm volatile("s_waitcnt lgkmcnt(0)" ::: "memory"); __builtin_amdgcn_s_barrier(); asm volatile("" ::: "memory"); } while (0)
#define TR_WAIT() do { asm volatile("s_waitcnt lgkmcnt(0)" ::: "memory"); __builtin_amdgcn_sched_barrier(0); } while (0)
__device__ __forceinline__ bf16x8 pk_lohi(v2u lo, v2u hi) { v4u w; w.x = lo.x; w.y = lo.y; w.z = hi.x; w.w = hi.y; return __builtin_bit_cast(bf16x8, w); }
__device__ __forceinline__ bf16x8 pk8(const unsigned (&h)[8]) { v4u w; w.x = h[0] | (h[1] << 16); w.y = h[2] | (h[3] << 16); w.z = h[4] | (h[5] << 16); w.w = h[6] | (h[7] << 16); return __builtin_bit_cast(bf16x8, w); }

constexpr int AT_KB = 17408, AT_VB = 18432, AT_BUF = AT_KB + AT_VB;
__device__ __forceinline__ void attn_unit(Ctx& F, int unit) {
    const int tid = F.tid, lane = F.lane, wave = F.wave, g16 = lane >> 4, c16 = lane & 15;
    const int b = unit >> 7, nblk = (unit >> 2) & 31, hk = (unit >> 1) & 1, gp = unit & 1;
    const int hq = hk * 4 + gp * 2 + (wave >> 2), r0 = (wave & 3) * 32;
    const bf16* PRJ = WSP(bf16, WS_R1); unsigned char* MIX = WSP(unsigned char, WS_MIX);
    const size_t tok0 = (size_t)b * SEQ + (size_t)nblk * 128;
    bf16x8 Qf[2][4];
#pragma unroll
    for (int nq = 0; nq < 2; ++nq)
#pragma unroll
        for (int kk = 0; kk < 4; ++kk) Qf[nq][kk] = *(const GAS bf16x8*)(PRJ + (tok0 + r0 + 16 * nq + c16) * NPRJ + C_QA + hq * 128 + 32 * kk + 8 * g16);
    const unsigned lbase = (unsigned)(uintptr_t)F.lds;
    const unsigned trl = (unsigned)((4 * g16 + (c16 >> 2)) * 288 + (c16 & 3) * 8);
    const int sj = tid >> 3, sd0 = (tid & 7) * 16;
    constexpr float QS = 0.08838834764831845f, QC = QS * 1.4426950408889634f;
    const float sink = F.attn_sink[hq] * (1.f / QS);
    float m_[2] = {sink, sink}, l_[2]; l_[0] = l_[1] = (g16 == 0) ? 1.f : 0.f;
    f32x4 O[8][2];
#pragma unroll
    for (int dt = 0; dt < 8; ++dt) { O[dt][0] = (f32x4){0.f, 0.f, 0.f, 0.f}; O[dt][1] = O[dt][0]; }
    const int n_t = (nblk == 0 || nblk == 31) ? 8 : 10;
    v4u kr[2], vr[2];
#define ATT_TILE(i) ((nblk == 0 && (i) >= 4) ? (i) + 2 : (i))
#define ATT_LOAD(t) do { const int _t = (t); size_t _row; if (_t < 4) _row = (size_t)T + b * CL + _t * 64 + sj; else { const int _bt = _t - 4; _row = (size_t)b * SEQ + (size_t)(nblk - 1 + (_bt >> 1)) * 128 + (_bt & 1) * 64 + sj; } \
        const bf16* _p = PRJ + _row * NPRJ + hk * 128 + sd0; kr[0] = *(const GAS v4u*)(_p + C_KA); kr[1] = *(const GAS v4u*)(_p + C_KA + 8); vr[0] = *(const GAS v4u*)(_p + C_VA); vr[1] = *(const GAS v4u*)(_p + C_VA + 8); } while (0)
#define ATT_WRITE(bufi) do { LAS bf16* _k = (LAS bf16*)(F.lds + (bufi) * AT_BUF); LAS bf16* _v = (LAS bf16*)(F.lds + (bufi) * AT_BUF + AT_KB); \
        *(LAS v4u*)(_k + sj * 136 + sd0) = kr[0]; *(LAS v4u*)(_k + sj * 136 + sd0 + 8) = kr[1]; *(LAS v4u*)(_v + sj * 144 + sd0) = vr[0]; *(LAS v4u*)(_v + sj * 144 + sd0 + 8) = vr[1]; } while (0)
    ATT_LOAD(ATT_TILE(0));
    LDS_BARRIER();
    ATT_WRITE(0);
    if (n_t > 1) ATT_LOAD(ATT_TILE(1));
    for (int i = 0; i < n_t; ++i) {
        const int t = ATT_TILE(i), cur = i & 1;
        LDS_BARRIER();
        if (i + 1 < n_t) ATT_WRITE(cur ^ 1);
        if (i + 2 < n_t) ATT_LOAD(ATT_TILE(i + 2));
        const LAS bf16* KT = (const LAS bf16*)(F.lds + cur * AT_BUF);
        const unsigned vaddr = lbase + cur * AT_BUF + AT_KB + trl;
        const bool band = t >= 4; const int bt = t - 4;
        bool rel = true, msk = false;
        if (band) { const int lo = 64 * bt - 128 - (r0 + 31), hi = 64 * bt + 63 - 128 - r0; rel = (lo <= 128) && (hi >= -128); msk = (lo < -128) || (hi > 128); }
        if (rel) {
            f32x4 S[4][2];
#pragma unroll
            for (int mt = 0; mt < 4; ++mt) { S[mt][0] = (f32x4){0.f, 0.f, 0.f, 0.f}; S[mt][1] = S[mt][0]; }
#pragma unroll
            for (int kk = 0; kk < 4; ++kk)
#pragma unroll
                for (int mt = 0; mt < 4; ++mt) { const bf16x8 Kf = *(const LAS bf16x8*)(KT + (16 * mt + c16) * 136 + 32 * kk + 8 * g16);
                    S[mt][0] = __builtin_amdgcn_mfma_f32_16x16x32_bf16(Kf, Qf[0][kk], S[mt][0], 0, 0, 0); S[mt][1] = __builtin_amdgcn_mfma_f32_16x16x32_bf16(Kf, Qf[1][kk], S[mt][1], 0, 0, 0); }
            if (msk) {
#pragma unroll
                for (int nq = 0; nq < 2; ++nq)
#pragma unroll
                    for (int mt = 0; mt < 4; ++mt)
#pragma unroll
                        for (int r = 0; r < 4; ++r) { const int rl = (64 * bt + 16 * mt + 4 * g16 + r) - 128 - (r0 + 16 * nq + c16); if (rl > 128 || rl < -128) S[mt][nq][r] = -INFINITY; }
            }
#pragma unroll
            for (int nq = 0; nq < 2; ++nq) {
                float tmax = fmaxf(fmaxf(fmaxf(S[0][nq][0], S[0][nq][1]), fmaxf(S[0][nq][2], S[0][nq][3])), fmaxf(fmaxf(S[1][nq][0], S[1][nq][1]), fmaxf(S[1][nq][2], S[1][nq][3])));
                tmax = fmaxf(tmax, fmaxf(fmaxf(fmaxf(S[2][nq][0], S[2][nq][1]), fmaxf(S[2][nq][2], S[2][nq][3])), fmaxf(fmaxf(S[3][nq][0], S[3][nq][1]), fmaxf(S[3][nq][2], S[3][nq][3]))));
                tmax = fmaxf(tmax, __shfl_xor(tmax, 16)); tmax = fmaxf(tmax, __shfl_xor(tmax, 32));
                const float mnew = fmaxf(m_[nq], tmax), alpha = __builtin_amdgcn_exp2f((m_[nq] - mnew) * QC), mc = -mnew * QC; m_[nq] = mnew;
                float ps = 0.f;
#pragma unroll
                for (int mt = 0; mt < 4; ++mt)
#pragma unroll
                    for (int r = 0; r < 4; ++r) { const float p = __builtin_amdgcn_exp2f(__builtin_fmaf(S[mt][nq][r], QC, mc)); S[mt][nq][r] = p; ps += p; }
                l_[nq] = l_[nq] * alpha + ps;
                if (__builtin_amdgcn_ballot_w64(alpha != 1.f) != 0ull) {
#pragma unroll
                    for (int dt = 0; dt < 8; ++dt) O[dt][nq] = O[dt][nq] * alpha; }
            }
#pragma unroll
            for (int kk = 0; kk < 2; ++kk) {
                bf16x8 Pf[2];
#pragma unroll
                for (int nq = 0; nq < 2; ++nq) { v4u w; w.x = pk2(S[2 * kk][nq][0], S[2 * kk][nq][1]); w.y = pk2(S[2 * kk][nq][2], S[2 * kk][nq][3]); w.z = pk2(S[2 * kk + 1][nq][0], S[2 * kk + 1][nq][1]); w.w = pk2(S[2 * kk + 1][nq][2], S[2 * kk + 1][nq][3]);
                    Pf[nq] = __builtin_bit_cast(bf16x8, w); }
                v2u vl[8], vh[8];
                { const unsigned vb = vaddr + kk * 9216;
                    vl[0] = tr_rdo<0>(vb); vh[0] = tr_rdo<4608>(vb); vl[1] = tr_rdo<32>(vb); vh[1] = tr_rdo<32 + 4608>(vb); vl[2] = tr_rdo<64>(vb); vh[2] = tr_rdo<64 + 4608>(vb); vl[3] = tr_rdo<96>(vb); vh[3] = tr_rdo<96 + 4608>(vb);
                    vl[4] = tr_rdo<128>(vb); vh[4] = tr_rdo<128 + 4608>(vb); vl[5] = tr_rdo<160>(vb); vh[5] = tr_rdo<160 + 4608>(vb); vl[6] = tr_rdo<192>(vb); vh[6] = tr_rdo<192 + 4608>(vb); vl[7] = tr_rdo<224>(vb); vh[7] = tr_rdo<224 + 4608>(vb); }
                TR_WAIT();
#pragma unroll
                for (int dt = 0; dt < 8; ++dt) { const bf16x8 Vf = pk_lohi(vl[dt], vh[dt]);
                    O[dt][0] = __builtin_amdgcn_mfma_f32_16x16x32_bf16(Vf, Pf[0], O[dt][0], 0, 0, 0); O[dt][1] = __builtin_amdgcn_mfma_f32_16x16x32_bf16(Vf, Pf[1], O[dt][1], 0, 0, 0); }
            }
        }
    }
#undef ATT_TILE
#undef ATT_LOAD
#undef ATT_WRITE
#pragma unroll
    for (int nq = 0; nq < 2; ++nq) {
        float l = l_[nq]; l += __shfl_xor(l, 16); l += __shfl_xor(l, 32); const float inv = 1.f / l;
        unsigned char* op = MIX + (tok0 + r0 + 16 * nq + c16) * DM + hq * 128 + 4 * g16;
#pragma unroll
        for (int dt = 0; dt < 8; ++dt) { const f32x4 o = O[dt][nq] * inv; *(GAS unsigned*)(op + 16 * dt) = pk4_fp8(o[0], o[1], o[2], o[3]); }
    }
}

constexpr int GW_KD = 0, GW_V = 18432, GW_DEC = 18432 + 34816;
__device__ __forceinline__ void gla_passA_wide(Ctx& F, int unit) {
    const int tid = F.tid, lane = F.lane, wave = F.wave, g16 = lane >> 4, c16 = lane & 15;
    const int uw = unit >> 3, sc8 = unit & 7, b = uw >> 3, h = (uw >> 1) & 3, dir = uw & 1;
    const int p_begin = sc8 == 0 ? 0 : 4 + 8 * (sc8 - 1), nch = sc8 == 0 ? 4 : 8;
    const char* PRJc = (const char*)WSP(bf16, WS_R1); const char* GBc = (const char*)WSP(bf16, WS_GB);
    LAS bf16* KD = (LAS bf16*)(F.lds + GW_KD); LAS bf16* VL = (LAS bf16*)(F.lds + GW_V); LAS float* DEC = (LAS float*)(F.lds + GW_DEC);
    const unsigned lbase = (unsigned)(uintptr_t)F.lds;
    const unsigned trk = (unsigned)((4 * g16 + (c16 >> 2)) * 288 + (c16 & 3) * 8), trv = (unsigned)((4 * g16 + (c16 >> 2)) * 544 + (c16 & 3) * 8);
    bf16x8 Wh;
    { unsigned hi[8];
#pragma unroll
        for (int j = 0; j < 8; ++j) { const float w = g16 < 2 ? F.w_gate_up[(size_t)(dir * 16 + 8 * g16 + j) * 512 + h * 128 + 16 * wave + c16] : 0.f; hi[j] = f2bf(w); }
        Wh = pk8(hi); }
    const float bup = F.b_gate[dir * 512 + h * 128 + 16 * wave + c16];
    bf16x8 U00, U01, UONE;
    { unsigned a0[8], a1[8], one[8];
#pragma unroll
        for (int j = 0; j < 8; ++j) { const int is = 16 * (j >> 2) + 4 * g16 + (j & 3); a0[j] = (is <= c16) ? 0x3F80u : 0u; a1[j] = (is <= 16 + c16) ? 0x3F80u : 0u; one[j] = 0x3F80u; }
        U00 = pk8(a0); U01 = pk8(a1); UONE = pk8(one); }
    const int wr = wave >> 1, wc = wave & 1, sgn = dir ? -1 : 1;
    const int sj = tid >> 3, sd0 = (tid & 7) * 32;
    const int o_gb = sgn * c16 * 64 + (dir * 16 + 8 * (g16 & 1)) * 2;
    const int o_v = sgn * sj * (NPRJ * 2) + (C_VB + h * 256 + sd0) * 2;
    const int o_k = sgn * c16 * (NPRJ * 2) + (C_KB + h * 128 + 16 * wave + 4 * g16) * 2;
    f32x4 Sw[2][8];
#pragma unroll
    for (int mt = 0; mt < 2; ++mt)
#pragma unroll
        for (int nt = 0; nt < 8; ++nt) Sw[mt][nt] = (f32x4){0.f, 0.f, 0.f, 0.f};
    f32x4 logd4 = {0.f, 0.f, 0.f, 0.f};
    v4u gq[4], vr[4]; v2u k4[4];
#define GW_RBASE(pp) ((pp) < 4 ? (T + b * CL + (dir ? (CL - 1 - 64 * (pp)) : 64 * (pp))) : (b * SEQ + (dir ? (SEQ - 1 - 64 * ((pp) - 4)) : 64 * ((pp) - 4))))
#define GW_LOAD(pp) do { const int _rb = GW_RBASE(pp); const char* _gp = GBc + (size_t)_rb * 64; const char* _pp = PRJc + (size_t)_rb * (NPRJ * 2); \
        _Pragma("unroll") for (int mi = 0; mi < 4; ++mi) gq[mi] = *(const GAS v4u*)(_gp + (o_gb + sgn * mi * 1024)); \
        _Pragma("unroll") for (int q = 0; q < 4; ++q) vr[q] = *(const GAS v4u*)(_pp + (o_v + 16 * q)); \
        _Pragma("unroll") for (int ni = 0; ni < 4; ++ni) k4[ni] = *(const GAS v2u*)(_pp + (o_k + sgn * ni * (16 * NPRJ * 2))); } while (0)
    GW_LOAD(p_begin);
    for (int ch = 0; ch < nch; ++ch) {
        const int p = p_begin + ch;
        f32x4 la[4];
#pragma unroll
        for (int mi = 0; mi < 4; ++mi) { const f32x4 zero = {0.f, 0.f, 0.f, 0.f};
            const f32x4 z = __builtin_amdgcn_mfma_f32_16x16x32_bf16(__builtin_bit_cast(bf16x8, gq[mi]), Wh, zero, 0, 0, 0);
#pragma unroll
            for (int r = 0; r < 4; ++r) { const float zz = fmaxf(z[r] + bup, -80.f); la[mi][r] = __builtin_amdgcn_logf(1.f + __builtin_amdgcn_exp2f(zz * -1.4426950408889634f)) * (-1.f / 16.f); } }
        f32x4 bT[4];
        {
            bf16x8 Lh[2];
#pragma unroll
            for (int kk = 0; kk < 2; ++kk) { v4u w; w.x = pk2(la[2 * kk][0], la[2 * kk][1]); w.y = pk2(la[2 * kk][2], la[2 * kk][3]); w.z = pk2(la[2 * kk + 1][0], la[2 * kk + 1][1]); w.w = pk2(la[2 * kk + 1][2], la[2 * kk + 1][3]); Lh[kk] = __builtin_bit_cast(bf16x8, w); }
            const f32x4 zero = {0.f, 0.f, 0.f, 0.f};
            bT[0] = __builtin_amdgcn_mfma_f32_16x16x32_bf16(Lh[0], U00, zero, 0, 0, 0);
            bT[1] = __builtin_amdgcn_mfma_f32_16x16x32_bf16(Lh[0], U01, zero, 0, 0, 0);
            bT[2] = __builtin_amdgcn_mfma_f32_16x16x32_bf16(Lh[0], UONE, zero, 0, 0, 0);
            bT[3] = bT[2];
            bT[2] = __builtin_amdgcn_mfma_f32_16x16x32_bf16(Lh[1], U00, bT[2], 0, 0, 0);
            bT[3] = __builtin_amdgcn_mfma_f32_16x16x32_bf16(Lh[1], U01, bT[3], 0, 0, 0);
        }
        f32x4 blast, dcv;
#pragma unroll
        for (int r = 0; r < 4; ++r) { blast[r] = __shfl(bT[3][r], (lane & 48) | 15); dcv[r] = __builtin_amdgcn_exp2f(blast[r]); }
        logd4 += blast;
        LDS_BARRIER();
#pragma unroll
        for (int q = 0; q < 4; ++q) *(LAS v4u*)(VL + sj * 272 + sd0 + 8 * q) = vr[q];
        if (c16 == 0) *(LAS f32x4*)(DEC + 16 * wave + 4 * g16) = dcv;
#pragma unroll
        for (int ni = 0; ni < 4; ++ni) {
            f32x4 kf, kdv;
            kf[0] = bf2f(k4[ni].x & 0xffffu); kf[1] = bf2f(k4[ni].x >> 16); kf[2] = bf2f(k4[ni].y & 0xffffu); kf[3] = bf2f(k4[ni].y >> 16);
#pragma unroll
            for (int r = 0; r < 4; ++r) kdv[r] = kf[r] * __builtin_amdgcn_exp2f(blast[r] - bT[ni][r]);
            v2u w; w.x = pk2(kdv[0], kdv[1]); w.y = pk2(kdv[2], kdv[3]); *(LAS v2u*)(KD + (16 * ni + c16) * 144 + 16 * wave + 4 * g16) = w;
        }
        LDS_BARRIER();
        if (ch + 1 < nch) GW_LOAD(p + 1);
        {
            const unsigned ka = lbase + GW_KD + trk + 64 * wr, va = lbase + GW_V + trv + 256 * wc;
            v2u al[2][2], ah[2][2];
            al[0][0] = tr_rdo<0>(ka); ah[0][0] = tr_rdo<4608>(ka); al[0][1] = tr_rdo<32>(ka); ah[0][1] = tr_rdo<32 + 4608>(ka);
            al[1][0] = tr_rdo<9216>(ka); ah[1][0] = tr_rdo<9216 + 4608>(ka); al[1][1] = tr_rdo<9216 + 32>(ka); ah[1][1] = tr_rdo<9216 + 32 + 4608>(ka);
            f32x4 dc[2];
#pragma unroll
            for (int mt = 0; mt < 2; ++mt) dc[mt] = *(const LAS f32x4*)(DEC + 32 * wr + 16 * mt + 4 * g16);
            TR_WAIT();
#pragma unroll
            for (int mt = 0; mt < 2; ++mt)
#pragma unroll
                for (int nt = 0; nt < 8; ++nt) Sw[mt][nt] = Sw[mt][nt] * dc[mt];
#define GW_VPAIR(NT, K) pk_lohi(tr_rdo<(K) * 17408 + (NT) * 32>(va), tr_rdo<(K) * 17408 + (NT) * 32 + 8704>(va))
#define GW_MM(NT, v0, v1) do { \
                Sw[0][NT] = __builtin_amdgcn_mfma_f32_16x16x32_bf16(pk_lohi(al[0][0], ah[0][0]), v0, Sw[0][NT], 0, 0, 0); Sw[1][NT] = __builtin_amdgcn_mfma_f32_16x16x32_bf16(pk_lohi(al[0][1], ah[0][1]), v0, Sw[1][NT], 0, 0, 0); \
                Sw[0][NT] = __builtin_amdgcn_mfma_f32_16x16x32_bf16(pk_lohi(al[1][0], ah[1][0]), v1, Sw[0][NT], 0, 0, 0); Sw[1][NT] = __builtin_amdgcn_mfma_f32_16x16x32_bf16(pk_lohi(al[1][1], ah[1][1]), v1, Sw[1][NT], 0, 0, 0); } while (0)
            { const bf16x8 a0 = GW_VPAIR(0, 0), a1 = GW_VPAIR(0, 1), b0 = GW_VPAIR(1, 0), b1 = GW_VPAIR(1, 1), c0 = GW_VPAIR(2, 0), c1 = GW_VPAIR(2, 1), d0 = GW_VPAIR(3, 0), d1 = GW_VPAIR(3, 1); TR_WAIT();
              GW_MM(0, a0, a1); GW_MM(1, b0, b1); GW_MM(2, c0, c1); GW_MM(3, d0, d1); }
            { const bf16x8 a0 = GW_VPAIR(4, 0), a1 = GW_VPAIR(4, 1), b0 = GW_VPAIR(5, 0), b1 = GW_VPAIR(5, 1), c0 = GW_VPAIR(6, 0), c1 = GW_VPAIR(6, 1), d0 = GW_VPAIR(7, 0), d1 = GW_VPAIR(7, 1); TR_WAIT();
              GW_MM(4, a0, a1); GW_MM(5, b0, b1); GW_MM(6, c0, c1); GW_MM(7, d0, d1); }
#undef GW_MM
#define GW_STEP(x)
#undef GW_STEP
#undef GW_VPAIR
        }
    }
#undef GW_LOAD
#undef GW_RBASE
    LDS_BARRIER();
    v2u* L = WSP(v2u, WS_GL) + ((size_t)(unit * 8 + wave) * 16) * 64 + lane;
#pragma unroll
    for (int mt = 0; mt < 2; ++mt)
#pragma unroll
        for (int nt = 0; nt < 8; ++nt) { v2u w; w.x = pk2(Sw[mt][nt][0], Sw[mt][nt][1]); w.y = pk2(Sw[mt][nt][2], Sw[mt][nt][3]); *(GAS v2u*)(L + (mt * 8 + nt) * 64) = w; }
    if (c16 == 0) *(GAS f32x4*)(WSP(float, WS_GLD) + unit * 128 + 16 * wave + 4 * g16) = logd4;
}
constexpr int GC_QM = 0, GC_KM = 17408, GC_QD = 34816, GC_KD = 52224, GC_V = 70656, GC_AT = 105472, GC_DEC = 114688;
__device__ __forceinline__ void gla_passC_wide(Ctx& F, int unit) {
    const int tid = F.tid, lane = F.lane, wave = F.wave, g16 = lane >> 4, c16 = lane & 15;
    const int uw = unit >> 3, sc8c = unit & 7, b = uw >> 3, h = (uw >> 1) & 3, dir = uw & 1;
    const char* PRJc = (const char*)WSP(bf16, WS_R1); const char* GBc = (const char*)WSP(bf16, WS_GB);
    char* OFBc = (char*)(WSP(bf16, WS_R2) + (size_t)dir * T * 1024);
    LAS bf16* QM = (LAS bf16*)(F.lds + GC_QM); LAS bf16* KM = (LAS bf16*)(F.lds + GC_KM); LAS bf16* QD = (LAS bf16*)(F.lds + GC_QD);
    LAS bf16* KD = (LAS bf16*)(F.lds + GC_KD); LAS bf16* VL = (LAS bf16*)(F.lds + GC_V); LAS bf16* AT = (LAS bf16*)(F.lds + GC_AT); LAS float* DEC = (LAS float*)(F.lds + GC_DEC);
    const unsigned lbase = (unsigned)(uintptr_t)F.lds;
    const unsigned trk = (unsigned)((4 * g16 + (c16 >> 2)) * 288 + (c16 & 3) * 8), trv = (unsigned)((4 * g16 + (c16 >> 2)) * 544 + (c16 & 3) * 8);
    bf16x8 Wh;
    { unsigned hi[8];
#pragma unroll
        for (int j = 0; j < 8; ++j) { const float w = g16 < 2 ? F.w_gate_up[(size_t)(dir * 16 + 8 * g16 + j) * 512 + h * 128 + 16 * wave + c16] : 0.f; hi[j] = f2bf(w); }
        Wh = pk8(hi); }
    const float bup = F.b_gate[dir * 512 + h * 128 + 16 * wave + c16];
    bf16x8 U00, U01, UONE;
    { unsigned a0[8], a1[8], one[8];
#pragma unroll
        for (int j = 0; j < 8; ++j) { const int is = 16 * (j >> 2) + 4 * g16 + (j & 3); a0[j] = (is <= c16) ? 0x3F80u : 0u; a1[j] = (is <= 16 + c16) ? 0x3F80u : 0u; one[j] = 0x3F80u; }
        U00 = pk8(a0); U01 = pk8(a1); UONE = pk8(one); }
    const int sgn = dir ? -1 : 1;
    const int sj = tid >> 3, sd0 = (tid & 7) * 32;
    const int o_gb = sgn * c16 * 64 + (dir * 16 + 8 * (g16 & 1)) * 2;
    const int o_v = sgn * sj * (NPRJ * 2) + (C_VB + h * 256 + sd0) * 2;
    const int o_qk = sgn * c16 * (NPRJ * 2) + (h * 128 + 16 * wave + 4 * g16) * 2;
    const int o_out = sgn * c16 * 2048 + (h * 256 + 32 * wave + 4 * g16) * 2;
    f32x4 Sc[8][2];
#ifdef PROBE_FOLD
    for (int rep_ = 0; rep_ < PROBE_FOLD; ++rep_)
#endif
    {
#ifdef PROBE_FOLD
        size_t zo_ = 0; asm volatile("" : "+s"(zo_));
        const v2u* Lb = WSP(v2u, WS_GL) + zo_ + (size_t)(uw * 8) * 8 * 16 * 64 + lane;
#else
        const v2u* Lb = WSP(v2u, WS_GL) + (size_t)(uw * 8) * 8 * 16 * 64 + lane;
#endif
        const float* LD = WSP(float, WS_GLD) + (size_t)uw * 8 * 128;
#define GC_LST(w_) ((f32x4){bf2f((w_).x & 0xffffu), __builtin_bit_cast(float, (w_).x & 0xffff0000u), bf2f((w_).y & 0xffffu), __builtin_bit_cast(float, (w_).y & 0xffff0000u)})
#pragma unroll
        for (int mt = 0; mt < 8; ++mt)
#pragma unroll
            for (int nt = 0; nt < 2; ++nt) { const int dvt = 2 * wave + nt; const v2u w = *(const GAS v2u*)(Lb + ((size_t)(2 * (mt >> 1) + (dvt >> 3)) * 16 + ((mt & 1) * 8 + (dvt & 7))) * 64); Sc[mt][nt] = GC_LST(w); }
        for (int s = 1; s <= sc8c; ++s) {
#pragma unroll
            for (int mt = 0; mt < 8; ++mt) { const f32x4 ld = *(const GAS f32x4*)(LD + s * 128 + 16 * mt + 4 * g16);
                const f32x4 dc = {__builtin_amdgcn_exp2f(ld.x), __builtin_amdgcn_exp2f(ld.y), __builtin_amdgcn_exp2f(ld.z), __builtin_amdgcn_exp2f(ld.w)};
#pragma unroll
                for (int nt = 0; nt < 2; ++nt) { const int dvt = 2 * wave + nt; const v2u w = *(const GAS v2u*)(Lb + ((size_t)s * 8 * 16 + (size_t)(2 * (mt >> 1) + (dvt >> 3)) * 16 + ((mt & 1) * 8 + (dvt & 7))) * 64); Sc[mt][nt] = Sc[mt][nt] * dc + GC_LST(w); } }
        }
#undef GC_LST
    }
    for (int i = tid; i < 64 * 72 / 2; i += 512) ((LAS unsigned*)AT)[i] = 0u;
    const int p_begin = 4 + 8 * sc8c;
    v4u gq[4], vr[4]; v2u k4[4], q4[4];
#define GC_RBASE(pp) (b * SEQ + (dir ? (SEQ - 1 - 64 * ((pp) - 4)) : 64 * ((pp) - 4)))
#define GC_LOAD(pp) do { const int _rb = GC_RBASE(pp); const char* _gp = GBc + (size_t)_rb * 64; const char* _pp = PRJc + (size_t)_rb * (NPRJ * 2); \
        _Pragma("unroll") for (int mi = 0; mi < 4; ++mi) gq[mi] = *(const GAS v4u*)(_gp + (o_gb + sgn * mi * 1024)); \
        _Pragma("unroll") for (int q = 0; q < 4; ++q) vr[q] = *(const GAS v4u*)(_pp + (o_v + 16 * q)); \
        _Pragma("unroll") for (int ni = 0; ni < 4; ++ni) { k4[ni] = *(const GAS v2u*)(_pp + (o_qk + sgn * ni * (16 * NPRJ * 2) + C_KB * 2)); q4[ni] = *(const GAS v2u*)(_pp + (o_qk + sgn * ni * (16 * NPRJ * 2) + C_QB * 2)); } } while (0)
    GC_LOAD(p_begin);
    { char* op = OFBc + (size_t)GC_RBASE(p_begin) * 2048 + o_out;
#pragma unroll
        for (int tq = 0; tq < 4; ++tq)
#pragma unroll
            for (int nt = 0; nt < 2; ++nt) { v2u w; w.x = 0u; w.y = 0u; *(GAS v2u*)(op + sgn * tq * (16 * 2048) + 32 * nt) = w; } }
    for (int ch = 0; ch < 8; ++ch) {
        const int p = p_begin + ch;
        const int rbase = GC_RBASE(p);
        f32x4 la[4];
#pragma unroll
        for (int mi = 0; mi < 4; ++mi) { const f32x4 zero = {0.f, 0.f, 0.f, 0.f};
            const f32x4 z = __builtin_amdgcn_mfma_f32_16x16x32_bf16(__builtin_bit_cast(bf16x8, gq[mi]), Wh, zero, 0, 0, 0);
#pragma unroll
            for (int r = 0; r < 4; ++r) { const float zz = fmaxf(z[r] + bup, -80.f); la[mi][r] = __builtin_amdgcn_logf(1.f + __builtin_amdgcn_exp2f(zz * -1.4426950408889634f)) * (-1.f / 16.f); } }
        f32x4 bT[4];
        {
            bf16x8 Lh[2];
#pragma unroll
            for (int kk = 0; kk < 2; ++kk) { v4u w; w.x = pk2(la[2 * kk][0], la[2 * kk][1]); w.y = pk2(la[2 * kk][2], la[2 * kk][3]); w.z = pk2(la[2 * kk + 1][0], la[2 * kk + 1][1]); w.w = pk2(la[2 * kk + 1][2], la[2 * kk + 1][3]); Lh[kk] = __builtin_bit_cast(bf16x8, w); }
            const f32x4 zero = {0.f, 0.f, 0.f, 0.f};
            bT[0] = __builtin_amdgcn_mfma_f32_16x16x32_bf16(Lh[0], U00, zero, 0, 0, 0);
            bT[1] = __builtin_amdgcn_mfma_f32_16x16x32_bf16(Lh[0], U01, zero, 0, 0, 0);
            bT[2] = __builtin_amdgcn_mfma_f32_16x16x32_bf16(Lh[0], UONE, zero, 0, 0, 0);
            bT[3] = bT[2];
            bT[2] = __builtin_amdgcn_mfma_f32_16x16x32_bf16(Lh[1], U00, bT[2], 0, 0, 0);
            bT[3] = __builtin_amdgcn_mfma_f32_16x16x32_bf16(Lh[1], U01, bT[3], 0, 0, 0);
        }
        f32x4 bmid, blast;
#pragma unroll
        for (int r = 0; r < 4; ++r) { bmid[r] = __shfl(bT[1][r], (lane & 48) | 15); blast[r] = __shfl(bT[3][r], (lane & 48) | 15); }
        f32x4 c1, c2, c3, dcv;
#pragma unroll
        for (int r = 0; r < 4; ++r) { c1[r] = __builtin_amdgcn_exp2f(-bmid[r]) * 0.08838834764831845f; c2[r] = __builtin_amdgcn_exp2f(bmid[r]); c3[r] = __builtin_amdgcn_exp2f(blast[r] - bmid[r]); dcv[r] = __builtin_amdgcn_exp2f(blast[r]); }
        LDS_BARRIER();
#pragma unroll
        for (int q = 0; q < 4; ++q) *(LAS v4u*)(VL + sj * 272 + sd0 + 8 * q) = vr[q];
        if (c16 == 0) *(LAS f32x4*)(DEC + 16 * wave + 4 * g16) = dcv;
#pragma unroll
        for (int ni = 0; ni < 4; ++ni) {
            const int i = 16 * ni + c16, dcol = 16 * wave + 4 * g16;
            f32x4 kf, qf, E, R;
            kf[0] = bf2f(k4[ni].x & 0xffffu); kf[1] = bf2f(k4[ni].x >> 16); kf[2] = bf2f(k4[ni].y & 0xffffu); kf[3] = bf2f(k4[ni].y >> 16);
            qf[0] = bf2f(q4[ni].x & 0xffffu); qf[1] = bf2f(q4[ni].x >> 16); qf[2] = bf2f(q4[ni].y & 0xffffu); qf[3] = bf2f(q4[ni].y >> 16);
#pragma unroll
            for (int r = 0; r < 4; ++r) { E[r] = __builtin_amdgcn_exp2f(bT[ni][r]); R[r] = __builtin_amdgcn_rcpf(E[r]); }
            const f32x4 kmv = kf * c2 * R, kdv = kmv * c3, qmv = qf * c1 * E, qdv = qf * 0.08838834764831845f * E;
            v2u w; w.x = pk2(kdv[0], kdv[1]); w.y = pk2(kdv[2], kdv[3]); *(LAS v2u*)(KD + i * 144 + dcol) = w;
            w.x = pk2(qmv[0], qmv[1]); w.y = pk2(qmv[2], qmv[3]); *(LAS v2u*)(QM + i * 136 + dcol) = w;
            w.x = pk2(kmv[0], kmv[1]); w.y = pk2(kmv[2], kmv[3]); *(LAS v2u*)(KM + i * 136 + dcol) = w;
            w.x = pk2(qdv[0], qdv[1]); w.y = pk2(qdv[2], qdv[3]); *(LAS v2u*)(QD + i * 136 + dcol) = w;
        }
        LDS_BARRIER();
        if (ch + 1 < 8) GC_LOAD(p + 1);
        for (int tl = wave; tl < 10; tl += 8) {
            const int tq = tl >= 6 ? 3 : tl >= 3 ? 2 : tl >= 1 ? 1 : 0, mt = tl - (tq * (tq + 1)) / 2;
            f32x4 a = {0.f, 0.f, 0.f, 0.f};
#pragma unroll
            for (int kk = 0; kk < 4; ++kk) { const bf16x8 Qf = *(const LAS bf16x8*)(QM + (16 * tq + c16) * 136 + 32 * kk + 8 * g16), Kf = *(const LAS bf16x8*)(KM + (16 * mt + c16) * 136 + 32 * kk + 8 * g16);
                a = __builtin_amdgcn_mfma_f32_16x16x32_bf16(Kf, Qf, a, 0, 0, 0); }
            if (mt == tq) {
#pragma unroll
                for (int r = 0; r < 4; ++r) if (4 * g16 + r > c16) a[r] = 0.f; }
            v2u w; w.x = pk2(a[0], a[1]); w.y = pk2(a[2], a[3]); *(LAS v2u*)(AT + (16 * tq + c16) * 72 + 16 * mt + 4 * g16) = w;
        }
        LDS_BARRIER();
        const unsigned va = lbase + GC_V + trv + 64 * wave;
        bf16x8 Vf[2][2];
        Vf[0][0] = pk_lohi(tr_rdo<0>(va), tr_rdo<8704>(va)); Vf[0][1] = pk_lohi(tr_rdo<17408>(va), tr_rdo<17408 + 8704>(va));
        Vf[1][0] = pk_lohi(tr_rdo<32>(va), tr_rdo<32 + 8704>(va)); Vf[1][1] = pk_lohi(tr_rdo<17408 + 32>(va), tr_rdo<17408 + 32 + 8704>(va));
        TR_WAIT();
        f32x4 OT[2][4];
#pragma unroll
        for (int nt = 0; nt < 2; ++nt)
#pragma unroll
            for (int tq = 0; tq < 4; ++tq) OT[nt][tq] = (f32x4){0.f, 0.f, 0.f, 0.f};
#pragma unroll
        for (int tq = 0; tq < 4; ++tq)
#pragma unroll
            for (int kk = 0; kk < 2; ++kk) if (kk == 0 || tq >= 2) {
                const LAS bf16* ap = AT + (16 * tq + c16) * 72 + 32 * kk + 4 * g16;
                const bf16x8 Af = pk_lohi(*(const LAS v2u*)ap, *(const LAS v2u*)(ap + 16));
                OT[0][tq] = __builtin_amdgcn_mfma_f32_16x16x32_bf16(Vf[0][kk], Af, OT[0][tq], 0, 0, 0); OT[1][tq] = __builtin_amdgcn_mfma_f32_16x16x32_bf16(Vf[1][kk], Af, OT[1][tq], 0, 0, 0); }
#pragma unroll
        for (int kq = 0; kq < 4; ++kq) {
            bf16x8 Sf[2];
#pragma unroll
            for (int nt = 0; nt < 2; ++nt) { v4u w; w.x = pk2(Sc[2 * kq][nt][0], Sc[2 * kq][nt][1]); w.y = pk2(Sc[2 * kq][nt][2], Sc[2 * kq][nt][3]); w.z = pk2(Sc[2 * kq + 1][nt][0], Sc[2 * kq + 1][nt][1]); w.w = pk2(Sc[2 * kq + 1][nt][2], Sc[2 * kq + 1][nt][3]); Sf[nt] = __builtin_bit_cast(bf16x8, w); }
#pragma unroll
            for (int tq = 0; tq < 4; ++tq) { const LAS bf16* qp = QD + (16 * tq + c16) * 136 + 32 * kq + 4 * g16;
                const bf16x8 Qf = pk_lohi(*(const LAS v2u*)qp, *(const LAS v2u*)(qp + 16));
                OT[0][tq] = __builtin_amdgcn_mfma_f32_16x16x32_bf16(Sf[0], Qf, OT[0][tq], 0, 0, 0); OT[1][tq] = __builtin_amdgcn_mfma_f32_16x16x32_bf16(Sf[1], Qf, OT[1][tq], 0, 0, 0); }
        }
        { char* op = OFBc + (size_t)rbase * 2048 + o_out;
#pragma unroll
            for (int tq = 0; tq < 4; ++tq)
#pragma unroll
                for (int nt = 0; nt < 2; ++nt) { v2u w; w.x = pk2(OT[nt][tq][0], OT[nt][tq][1]); w.y = pk2(OT[nt][tq][2], OT[nt][tq][3]); *(GAS v2u*)(op + sgn * tq * (16 * 2048) + 32 * nt) = w; } }
        {
            const unsigned ka = lbase + GC_KD + trk;
#define GC_KPAIR(MT, K) pk_lohi(tr_rdo<(K) * 9216 + (MT) * 32>(ka), tr_rdo<(K) * 9216 + (MT) * 32 + 4608>(ka))
#define GC_MM(MT, k0, k1) do { const f32x4 dc = *(const LAS f32x4*)(DEC + 16 * (MT) + 4 * g16); Sc[MT][0] = Sc[MT][0] * dc; Sc[MT][1] = Sc[MT][1] * dc; \
                Sc[MT][0] = __builtin_amdgcn_mfma_f32_16x16x32_bf16(k0, Vf[0][0], Sc[MT][0], 0, 0, 0); Sc[MT][1] = __builtin_amdgcn_mfma_f32_16x16x32_bf16(k0, Vf[1][0], Sc[MT][1], 0, 0, 0); \
                Sc[MT][0] = __builtin_amdgcn_mfma_f32_16x16x32_bf16(k1, Vf[0][1], Sc[MT][0], 0, 0, 0); Sc[MT][1] = __builtin_amdgcn_mfma_f32_16x16x32_bf16(k1, Vf[1][1], Sc[MT][1], 0, 0, 0); } while (0)
#define GC_ROW2(M0) do { const bf16x8 a0 = GC_KPAIR(M0, 0), a1 = GC_KPAIR(M0, 1), b0 = GC_KPAIR((M0) + 1, 0), b1 = GC_KPAIR((M0) + 1, 1); TR_WAIT(); GC_MM(M0, a0, a1); GC_MM((M0) + 1, b0, b1); } while (0)
            GC_ROW2(0); GC_ROW2(2); GC_ROW2(4); GC_ROW2(6);
#undef GC_ROW2
#undef GC_MM
#define GC_ROW(x)
#undef GC_ROW
#undef GC_KPAIR
        }
    }
#undef GC_LOAD
#undef GC_RBASE
    LDS_BARRIER();
}
__device__ __forceinline__ void p6_gla_out(Ctx& F) {
    const bf16* OF = WSP(bf16, WS_R2); const bf16* OB = OF + (size_t)T * 1024; const bf16* PRJ = WSP(bf16, WS_R1); unsigned char* MIX = WSP(unsigned char, WS_MIX);
    const int gw = blockIdx.x * 8 + F.wave, NGW = F.G * 8, lane = F.lane;
    f32x4 nw[4];
#pragma unroll
    for (int j = 0; j < 4; ++j) nw[j] = *(const GAS f32x4*)(F.gla_norm_w + 16 * lane + 4 * j);
    v4u a0, a1, b0, b1, r0, r1;
#define P6_LOAD(t_) do { a0 = *(const GAS v4u*)(OF + (size_t)(t_) * 1024 + 16 * lane); a1 = *(const GAS v4u*)(OF + (size_t)(t_) * 1024 + 16 * lane + 8); \
        b0 = *(const GAS v4u*)(OB + (size_t)(t_) * 1024 + 16 * lane); b1 = *(const GAS v4u*)(OB + (size_t)(t_) * 1024 + 16 * lane + 8); \
        r0 = *(const GAS v4u*)(PRJ + (size_t)(t_) * NPRJ + C_RB + 16 * lane); r1 = *(const GAS v4u*)(PRJ + (size_t)(t_) * NPRJ + C_RB + 16 * lane + 8); } while (0)
    if (gw < T) P6_LOAD(gw);
    for (int t = gw; t < T; t += NGW) {
        float o[16], rv[16]; float ss = 0.f;
#pragma unroll
        for (int j = 0; j < 4; ++j) { o[2 * j] = bf2f(a0[j] & 0xffffu) + bf2f(b0[j] & 0xffffu); o[2 * j + 1] = bf2f(a0[j] >> 16) + bf2f(b0[j] >> 16); o[8 + 2 * j] = bf2f(a1[j] & 0xffffu) + bf2f(b1[j] & 0xffffu); o[8 + 2 * j + 1] = bf2f(a1[j] >> 16) + bf2f(b1[j] >> 16);
            rv[2 * j] = bf2f(r0[j] & 0xffffu); rv[2 * j + 1] = bf2f(r0[j] >> 16); rv[8 + 2 * j] = bf2f(r1[j] & 0xffffu); rv[8 + 2 * j + 1] = bf2f(r1[j] >> 16); }
        if (t + NGW < T) P6_LOAD(t + NGW);
#pragma unroll
        for (int j = 0; j < 16; ++j) ss += o[j] * o[j];
        ss += __shfl_xor(ss, 1); ss += __shfl_xor(ss, 2); ss += __shfl_xor(ss, 4); ss += __shfl_xor(ss, 8);
        const float rs = 1.f / sqrtf(ss * (1.f / 256.f) + LN_EPS);
        float y[16];
#pragma unroll
        for (int j = 0; j < 4; ++j)
#pragma unroll
            for (int e = 0; e < 4; ++e) y[4 * j + e] = o[4 * j + e] * rs * nw[j][e] * silu_f(rv[4 * j + e]);
        v4u w; w.x = pk4_fp8(y[0], y[1], y[2], y[3]); w.y = pk4_fp8(y[4], y[5], y[6], y[7]); w.z = pk4_fp8(y[8], y[9], y[10], y[11]); w.w = pk4_fp8(y[12], y[13], y[14], y[15]);
        *(GAS v4u*)(MIX + (size_t)t * DM + 1024 + 16 * lane) = w;
    }
#undef P6_LOAD
}


__device__ __forceinline__ f32x4 ld_bf4(const bf16* p) { const v2u w = *(const GAS v2u*)p; f32x4 r; r.x = bf2f(w.x & 0xffffu); r.y = bf2f(w.x >> 16); r.z = bf2f(w.y & 0xffffu); r.w = bf2f(w.y >> 16); return r; }
__device__ __forceinline__ void st_bf4(bf16* p, f32x4 v) { v2u w; w.x = pk2(v.x, v.y); w.y = pk2(v.z, v.w); *(GAS v2u*)p = w; }
struct EpiX1 {
    static constexpr bool PERM = true, AFTER_DRAIN = false;
    const float* x; const float* mod; bf16* X1; float sc;
    __device__ __forceinline__ void operator()(const f32x4 (&acc)[2][2][4][2], const pg8::Unit& u, int wr, int wc, int fr, int fq) const {
        const int row0 = u.pm * 256 + wr * 64 + fr, col0 = u.pn * 256 + wc * 32 + 8 * fq;
        const float* g1 = mod + (size_t)(u.pm >> 4) * NMOD + 2 * DM + col0;
        f32x4 gv[2][2];
#pragma unroll
        for (int bj = 0; bj < 2; ++bj)
#pragma unroll
            for (int n = 0; n < 2; ++n) gv[bj][n] = *(const GAS f32x4*)(g1 + bj * 128 + n * 4) * sc;
        f32x4 xa[2][2][2], xb[2][2][2];
#define X1_LOAD(dst, g) do { _Pragma("unroll") for (int mm = 0; mm < 2; ++mm) _Pragma("unroll") for (int bj = 0; bj < 2; ++bj) { const size_t off = (size_t)(row0 + ((g) >> 1) * 128 + (2 * ((g) & 1) + mm) * 16) * DM + col0 + bj * 128; \
            dst[mm][bj][0] = *(const GAS f32x4*)(x + off); dst[mm][bj][1] = *(const GAS f32x4*)(x + off + 4); } } while (0)
#define X1_STORE(src, g) do { _Pragma("unroll") for (int mm = 0; mm < 2; ++mm) _Pragma("unroll") for (int bj = 0; bj < 2; ++bj) { const int ai = (g) >> 1, m = 2 * ((g) & 1) + mm; const size_t off = (size_t)(row0 + ai * 128 + m * 16) * DM + col0 + bj * 128; \
            const f32x4 v0 = src[mm][bj][0] * ALPHA + gv[bj][0] * acc[ai][bj][m][0], v1 = src[mm][bj][1] * ALPHA + gv[bj][1] * acc[ai][bj][m][1]; \
            v4u w; w.x = pk2(v0[0], v0[1]); w.y = pk2(v0[2], v0[3]); w.z = pk2(v1[0], v1[1]); w.w = pk2(v1[2], v1[3]); *(GAS v4u*)(X1 + off) = w; } } while (0)
        X1_LOAD(xa, 0); X1_LOAD(xb, 1); X1_STORE(xa, 0); X1_LOAD(xa, 2); X1_STORE(xb, 1); X1_LOAD(xb, 3); X1_STORE(xa, 2); X1_STORE(xb, 3);
#undef X1_LOAD
#undef X1_STORE
    }
};
struct EpiSwiGLU {
    static constexpr bool PERM = true, AFTER_DRAIN = false;
    unsigned char* HID;
    __device__ __forceinline__ void operator()(const f32x4 (&acc)[2][2][4][2], const pg8::Unit& u, int wr, int wc, int fr, int fq) const {
        const int row0 = u.pm * 256 + wr * 64 + fr, col0 = u.pn * 128 + wc * 32 + 8 * fq;
#pragma unroll
        for (int ai = 0; ai < 2; ++ai)
#pragma unroll
            for (int m = 0; m < 4; ++m) { f32x4 h0, h1;
#pragma unroll
                for (int j = 0; j < 4; ++j) { h0[j] = silu_f(acc[ai][0][m][0][j] * W8_INV) * (acc[ai][1][m][0][j] * W8_INV); h1[j] = silu_f(acc[ai][0][m][1][j] * W8_INV) * (acc[ai][1][m][1][j] * W8_INV); }
                v2u w; w.x = pk4_fp8(h0[0], h0[1], h0[2], h0[3]); w.y = pk4_fp8(h1[0], h1[1], h1[2], h1[3]);
                *(GAS v2u*)(HID + (size_t)(row0 + ai * 128 + m * 16) * EH + col0) = w; }
    }
};
struct EpiPlain {
    static constexpr bool PERM = true, AFTER_DRAIN = false;
    unsigned char* O; int ldc; float sc;
    __device__ __forceinline__ void operator()(const f32x4 (&acc)[2][2][4][2], const pg8::Unit& u, int wr, int wc, int fr, int fq) const {
        const int row0 = u.pm * 256 + wr * 64 + fr, col0 = u.pn * 256 + wc * 32 + 8 * fq;
#pragma unroll
        for (int ai = 0; ai < 2; ++ai)
#pragma unroll
            for (int m = 0; m < 4; ++m) { unsigned char* rowp = O + (size_t)(row0 + ai * 128 + m * 16) * ldc + col0;
#pragma unroll
                for (int bj = 0; bj < 2; ++bj) { const f32x4 v0 = acc[ai][bj][m][0] * sc, v1 = acc[ai][bj][m][1] * sc;
                    v2u w; w.x = pk4_fp8(v0[0], v0[1], v0[2], v0[3]); w.y = pk4_fp8(v1[0], v1[1], v1[2], v1[3]); *(GAS v2u*)(rowp + bj * 128) = w; } }
    }
};
template <bool GATHER_>
struct MoeOrderT {
    static constexpr bool GATHER = GATHER_;
    int nM, nN, nwg, G, c; const LAS int* tile_e; const LAS int* rows;
    __device__ __forceinline__ bool next(int i, pg8::Unit& u) const {
        const int L = i * G + c; if (L >= nwg) return false;
        int wgid = L; { const int q = nwg / 8, r = nwg % 8, xcd = wgid % 8, off = wgid / 8; wgid = (xcd < r ? xcd * (q + 1) : r * (q + 1) + (xcd - r) * q) + off; }
        const int nig = 8 * nN, gid = wgid / nig, fm = gid * 8, gsz = (nM - fm) < 8 ? (nM - fm) : 8;
        u.pm = fm + ((wgid % nig) % gsz); u.pn = (wgid % nig) / gsz; u.e = __builtin_amdgcn_readfirstlane(tile_e[u.pm]); return true;
    }
    __device__ __forceinline__ void a_ready(const pg8::Unit&) const {}
    __device__ __forceinline__ void done(const pg8::Unit&) const {}
};
typedef MoeOrderT<false> MoeOrder; typedef MoeOrderT<true> MoeOrderG;

template <bool DRY = false>
__device__ __forceinline__ void p8_ln_route(Ctx& F) {
    const int wave = F.wave;
    const bf16* X1i = WSP(bf16, WS_X1); f32x2* ROWST = DRY ? WSP(f32x2, WS_R1) : WSP(f32x2, TOK_ROWST); unsigned char* H2 = DRY ? WSP(unsigned char, WS_R1 + 70 * MiB) : WSP(unsigned char, WS_R2); const float* MOD = WSP(float, WS_MOD);
    const bf16* WQH = WSP(bf16, WS_WQH); const bf16* WQL = WSP(bf16, WS_WQL); const float* UV = WSP(float, WS_UV);
    constexpr size_t DO = DRY ? (WS_R1 + 110 * MiB - WS_TOK) : 0;
    int* tok_e = WSP(int, TOK_E + DO); int* tok_rank = WSP(int, TOK_RANK + DO); float* tok_w = WSP(float, TOK_W + DO); int* cntblk = WSP(int, TOK_CNT + DO);
    LAS f32x4* STAT = (LAS f32x4*)(F.lds);
    LAS f32x4* CST = (LAS f32x4*)(F.lds + 32768);
    LAS float* LGP = (LAS float*)(F.lds + 65536);
    LAS float* UVL = (LAS float*)(F.lds + 1024);
    for (int vb = blockIdx.x; vb < 256; vb += F.G) {
        const int t0 = vb * 64, bb = t0 >> 12;
        const float* mrow = MOD + (size_t)bb * NMOD;
        int tz0_ = threadIdx.x; asm volatile("" : "+v"(tz0_));
        const int tid = tz0_, lane = tz0_ & 63, g16 = (tz0_ >> 4) & 3, c16 = tz0_ & 15;
        f32x4 a3[4][3];
#pragma unroll
        for (int tile = 0; tile < 4; ++tile)
#pragma unroll
            for (int nt = 0; nt < 3; ++nt) a3[tile][nt] = (f32x4){0.f, 0.f, 0.f, 0.f};
        {
            const f32x4 c0 = *(const GAS f32x4*)(F.ln1_g + 4 * tid), c1 = *(const GAS f32x4*)(F.ln1_b + 4 * tid), c2 = *(const GAS f32x4*)(mrow + 3 * DM + 4 * tid), c3 = *(const GAS f32x4*)(mrow + 4 * DM + 4 * tid);
            const int kw = 256 * wave + 8 * g16;
            const bf16* xr = X1i + (size_t)(t0 + c16) * DM + kw; const bf16* wh = WQH + (size_t)(bb * 48 + c16) * DM + kw; const bf16* wl = WQL + (size_t)(bb * 48 + c16) * DM + kw;
            bf16x8 xa[4], bh[3], bl[3];
#define P8_RLD(kk) do { \
                _Pragma("unroll") for (int nt = 0; nt < 3; ++nt) { bh[nt] = *(const GAS bf16x8*)(wh + (size_t)nt * 16 * DM + 32 * (kk)); bl[nt] = *(const GAS bf16x8*)(wl + (size_t)nt * 16 * DM + 32 * (kk)); } \
                _Pragma("unroll") for (int tile = 0; tile < 4; ++tile) xa[tile] = *(const GAS bf16x8*)(xr + (size_t)tile * 16 * DM + 32 * (kk)); } while (0)
            v2u nx[4][8];
#define P8_XLD(i_) do { _Pragma("unroll") for (int j = 0; j < 8; ++j) nx[(i_) & 3][j] = *(const GAS v2u*)(X1i + (size_t)(t0 + 8 * wave + (i_)) * DM + 4 * lane + 256 * j); } while (0)
            P8_XLD(0); P8_XLD(1); P8_RLD(0); P8_XLD(2); P8_XLD(3);
            CST[tid] = c0; CST[512 + tid] = c1; CST[1024 + tid] = c2; CST[1536 + tid] = c3 + 1.f;
            if (tid < 192) UVL[tid] = UV[bb * 192 + tid];
            __syncthreads();
#pragma unroll
            for (int i = 0; i < 8; ++i) {
                const int t = t0 + 8 * wave + i;
                unsigned co_ = 32768u + 16u * (unsigned)lane; asm volatile("" : "+v"(co_));
                const LAS f32x4* CSTl = (const LAS f32x4*)(F.lds + co_);
                f32x4 v[8]; f32x4 sv = {0.f, 0.f, 0.f, 0.f}, qv = {0.f, 0.f, 0.f, 0.f};
#pragma unroll
                for (int j = 0; j < 8; ++j) { const v2u w = nx[i & 3][j]; v[j].x = bf2f(w.x & 0xffffu); v[j].y = __builtin_bit_cast(float, w.x & 0xffff0000u); v[j].z = bf2f(w.y & 0xffffu); v[j].w = __builtin_bit_cast(float, w.y & 0xffff0000u);
                    sv += v[j]; qv = v[j] * v[j] + qv; }
                const float mean = wave_sum((sv.x + sv.y) + (sv.z + sv.w)) * (1.f / DM), ex2 = wave_sum((qv.x + qv.y) + (qv.z + qv.w)) * (1.f / DM);
                const float rstd = 1.f / sqrtf(fmaxf(ex2 - mean * mean, 0.f) + LN_EPS), nm = -mean * rstd;
                f32x4 sv2 = {0.f, 0.f, 0.f, 0.f}, qv2 = {0.f, 0.f, 0.f, 0.f};
#pragma unroll
                for (int j = 0; j < 8; ++j) { v[j] = (v[j] * rstd + nm) * CSTl[64 * j] + CSTl[512 + 64 * j]; sv2 += v[j]; qv2 = v[j] * v[j] + qv2; }
                const float mean2 = wave_sum((sv2.x + sv2.y) + (sv2.z + sv2.w)) * (1.f / DM), ey2 = wave_sum((qv2.x + qv2.y) + (qv2.z + qv2.w)) * (1.f / DM);
                const float rstd2 = 1.f / sqrtf(fmaxf(ey2 - mean2 * mean2, 0.f) + LN_EPS), nm2 = -mean2 * rstd2;
                unsigned hq[8];
#pragma unroll
                for (int j = 0; j < 8; ++j) { const f32x4 h = (v[j] * rstd2 + nm2) * CSTl[1536 + 64 * j] + CSTl[1024 + 64 * j]; hq[j] = pk4_fp8(h.x, h.y, h.z, h.w); }
#pragma unroll
                for (int tile = 0; tile < 4; ++tile)
#pragma unroll
                    for (int nt = 0; nt < 3; ++nt) { a3[tile][nt] = __builtin_amdgcn_mfma_f32_16x16x32_bf16(xa[tile], bh[nt], a3[tile][nt], 0, 0, 0); a3[tile][nt] = __builtin_amdgcn_mfma_f32_16x16x32_bf16(xa[tile], bl[nt], a3[tile][nt], 0, 0, 0); }
                if (i + 1 < 8) P8_RLD(i + 1);
                if (i + 4 < 8) P8_XLD(i + 4);
#pragma unroll
                for (int j = 0; j < 8; ++j) *(GAS unsigned*)(H2 + (size_t)t * DM + 4 * lane + 256 * j) = hq[j];
                if (lane == 0) { STAT[8 * wave + i] = (f32x4){mean, rstd, mean2, rstd2}; *(GAS f32x2*)(ROWST + t) = (f32x2){mean, rstd}; }
            }
#undef P8_RLD
#undef P8_XLD
        }
#define P8_LG(p_, tile, nt, r) LGP[((p_) * 64 + 16 * (tile) + 4 * g16 + (r)) * 52 + 16 * (nt) + c16]
        if (wave >= 4) {
#pragma unroll
            for (int tile = 0; tile < 4; ++tile)
#pragma unroll
                for (int nt = 0; nt < 3; ++nt)
#pragma unroll
                    for (int r = 0; r < 4; ++r) P8_LG(wave - 4, tile, nt, r) = a3[tile][nt][r];
        }
        __syncthreads();
        if (wave < 4) {
#pragma unroll
            for (int tile = 0; tile < 4; ++tile)
#pragma unroll
                for (int nt = 0; nt < 3; ++nt)
#pragma unroll
                    for (int r = 0; r < 4; ++r) P8_LG(wave, tile, nt, r) = a3[tile][nt][r] + P8_LG(wave, tile, nt, r);
        }
#undef P8_LG
        __syncthreads();
        if (wave == 0) {
            const int t = t0 + lane;
            const LAS float* lp = LGP + lane * 52;
            const f32x4 stt = STAT[lane]; const float ra = stt.y * stt.w, rc = -stt.z * stt.w; const LAS float* uv = UVL;
#define P8_L(c_) (ra * ((((lp[c_] + lp[64 * 52 + (c_)]) + lp[2 * 64 * 52 + (c_)]) + lp[3 * 64 * 52 + (c_)]) - stt.x * uv[c_]) + stt.w * uv[48 + (c_)] + rc * uv[96 + (c_)] + uv[144 + (c_)])
            float gmax = -INFINITY; int grp = 0; float gl[4];
#pragma unroll
            for (int j = 0; j < 4; ++j) { gl[j] = P8_L(j); if (gl[j] > gmax) { gmax = gl[j]; grp = j; } }
            float gs = 0.f;
#pragma unroll
            for (int j = 0; j < 4; ++j) gs += __expf(gl[j] - gmax);
            const float pg = 1.f / gs;
            float e1v = -INFINITY, e2v = -INFINITY; int i1 = 0, i2 = 0;
            for (int j = 0; j < 8; ++j) { const float v = P8_L(4 + grp * 8 + j);
                if (v > e1v) { e2v = e1v; i2 = i1; e1v = v; i1 = j; } else if (v > e2v) { e2v = v; i2 = j; } }
#undef P8_L
            const float w1 = 1.f / (1.f + __expf(e2v - e1v)), w2 = 1.f - w1;
            const int e0 = grp * 8 + i1, e1 = grp * 8 + i2;
            int rank0 = 0, rank1 = 0, mycnt = 0;
            const unsigned long long lt = (1ull << lane) - 1ull;
            for (int e = 0; e < NE; ++e) {
                const unsigned long long m0 = __ballot(e0 == e), m1 = __ballot(e1 == e);
                const int below = __popcll(m0 & lt) + __popcll(m1 & lt);
                if (e0 == e) rank0 = below; if (e1 == e) rank1 = below;
                if (lane == e) mycnt = __popcll(m0) + __popcll(m1);
            }
            if (lane < NE) cntblk[vb * NE + lane] = mycnt;
            tok_e[2 * t] = e0; tok_e[2 * t + 1] = e1; tok_rank[2 * t] = rank0; tok_rank[2 * t + 1] = rank1; tok_w[2 * t] = pg * w1; tok_w[2 * t + 1] = pg * w2;
        }
        __syncthreads();
    }
}
__device__ __forceinline__ void p9_gather(Ctx& F) {
    const int tid = F.tid;
    const int* cntblk = WSP(int, TOK_CNT); const int* tok_e = WSP(int, TOK_E); const int* tok_rank = WSP(int, TOK_RANK); int* tok_slot = WSP(int, TOK_SLOT); int* meta = WSP(int, TOK_META); int* perm = WSP(int, TOK_PERM);
    LAS int* PART = (LAS int*)F.lds;
    LAS int* TOT = PART + 1024;
    for (int vb = blockIdx.x; vb < 256; vb += F.G) {
        int te = 0, tr = 0;
        if (tid < 128) { te = tok_e[vb * 128 + tid]; tr = tok_rank[vb * 128 + tid]; }
        { const int e = tid & 31, part = tid >> 5; int tot = 0, pre = 0;
#pragma unroll
            for (int i = 0; i < 16; ++i) { const int v = 16 * part + i; const int c = cntblk[v * NE + e]; tot += c; if (v < vb) pre += c; }
            PART[part * 32 + e] = tot; PART[512 + part * 32 + e] = pre; }
        __syncthreads();
        if (tid < 32) { int tot = 0, pre = 0;
#pragma unroll
            for (int p = 0; p < 16; ++p) { tot += PART[p * 32 + tid]; pre += PART[512 + p * 32 + tid]; }
            TOT[tid] = tot; TOT[32 + tid] = pre;
            const int ntl = (tot + 255) >> 8; int inc = ntl;
#pragma unroll
            for (int o = 1; o < 32; o <<= 1) { const int n = __shfl_up(inc, o); if (tid >= o) inc += n; }
            const int exc = inc - ntl; TOT[64 + tid] = exc << 8;
            if (vb == 0) { for (int k = 0; k < ntl; ++k) if (exc + k < MAXTILES) meta[1 + exc + k] = tid;
                if (tid == 31) meta[0] = inc < MAXTILES ? inc : MAXTILES; } }
        __syncthreads();
        if (tid < 128) { const int dst = TOT[64 + te] + TOT[32 + te] + tr; tok_slot[vb * 128 + tid] = dst; perm[dst] = vb * 64 + (tid >> 1); }
        if (vb < NE) { const int cnt = TOT[vb], st = TOT[64 + vb], pad = ((cnt + 255) >> 8) << 8; for (int r = cnt + tid; r < pad; r += 512) perm[st + r] = 0; }
        __syncthreads();
    }
}
__device__ __forceinline__ void p12_final(Ctx& F) {
    const bf16* X1 = WSP(bf16, WS_X1); const unsigned char* EO = WSP(unsigned char, WS_R2); const float* MOD = WSP(float, WS_MOD);
    const int* tok_slot = WSP(int, TOK_SLOT); const float* tok_w = WSP(float, TOK_W);
    const int gw = blockIdx.x * 8 + F.wave, NGW = F.G * 8, lane = F.lane;
    const f32x2* ROWST = WSP(f32x2, TOK_ROWST);
    LAS f32x4* L1 = (LAS f32x4*)F.lds;
    L1[F.tid] = *(const GAS f32x4*)(F.ln1_g + 4 * F.tid); L1[512 + F.tid] = *(const GAS f32x4*)(F.ln1_b + 4 * F.tid);
    __syncthreads();
    f32x4 lg[8], lb[8];
#pragma unroll
    for (int j = 0; j < 8; ++j) { lg[j] = *(const GAS f32x4*)(F.ln2_g + 4 * lane + 256 * j); lb[j] = *(const GAS f32x4*)(F.ln2_b + 4 * lane + 256 * j); }
    int s0 = 0, s1 = 0; float w0 = 0.f, w1 = 0.f; f32x2 rs = {0.f, 0.f};
    if (gw < T) { s0 = tok_slot[2 * gw]; s1 = tok_slot[2 * gw + 1]; w0 = tok_w[2 * gw]; w1 = tok_w[2 * gw + 1]; rs = *(const GAS f32x2*)(ROWST + gw); }
    for (int t = gw; t < T; t += NGW) {
        const float* g2 = MOD + (size_t)(t >> 12) * NMOD + 5 * DM;
        unsigned ea[8], eb[8]; v2u xv[8]; f32x4 gg[8];
#pragma unroll
        for (int j = 0; j < 8; ++j) { const int cidx = 4 * lane + 256 * j;
            ea[j] = *(const GAS unsigned*)(EO + (size_t)s0 * DM + cidx); eb[j] = *(const GAS unsigned*)(EO + (size_t)s1 * DM + cidx); xv[j] = *(const GAS v2u*)(X1 + (size_t)t * DM + cidx); gg[j] = *(const GAS f32x4*)(g2 + cidx); }
        const float cw0 = w0, cw1 = w1, m1 = rs.x, r1 = rs.y;
        if (t + NGW < T) { s0 = tok_slot[2 * (t + NGW)]; s1 = tok_slot[2 * (t + NGW) + 1]; w0 = tok_w[2 * (t + NGW)]; w1 = tok_w[2 * (t + NGW) + 1]; rs = *(const GAS f32x2*)(ROWST + t + NGW); }
        f32x4 v[8]; f32x4 sv = {0.f, 0.f, 0.f, 0.f}, qv = {0.f, 0.f, 0.f, 0.f}; const float nm1 = -m1 * r1;
#pragma unroll
        for (int j = 0; j < 8; ++j) {
            const f32x2 a01 = __builtin_amdgcn_cvt_pk_f32_fp8((int)ea[j], false), a23 = __builtin_amdgcn_cvt_pk_f32_fp8((int)ea[j], true), b01 = __builtin_amdgcn_cvt_pk_f32_fp8((int)eb[j], false), b23 = __builtin_amdgcn_cvt_pk_f32_fp8((int)eb[j], true);
            const f32x4 fa = {a01.x, a01.y, a23.x, a23.y}, fb = {b01.x, b01.y, b23.x, b23.y}; const f32x4 f = fa * cw0 + fb * cw1;
            f32x4 x1; x1.x = bf2f(xv[j].x & 0xffffu); x1.y = __builtin_bit_cast(float, xv[j].x & 0xffff0000u); x1.z = bf2f(xv[j].y & 0xffffu); x1.w = __builtin_bit_cast(float, xv[j].y & 0xffff0000u);
            x1 = (x1 * r1 + nm1) * L1[lane + 64 * j] + L1[512 + lane + 64 * j];
            v[j] = x1 * ALPHA + gg[j] * f; sv += v[j]; qv = v[j] * v[j] + qv; }
        const float mean = wave_sum((sv.x + sv.y) + (sv.z + sv.w)) * (1.f / DM), ev2 = wave_sum((qv.x + qv.y) + (qv.z + qv.w)) * (1.f / DM);
        const float rstd = 1.f / sqrtf(fmaxf(ev2 - mean * mean, 0.f) + LN_EPS), nmr = -mean * rstd;
#pragma unroll
        for (int j = 0; j < 8; ++j) *(GAS f32x4*)(F.out + (size_t)t * DM + 4 * lane + 256 * j) = (v[j] * rstd + nmr) * lg[j] + lb[j];
    }
}

constexpr int NPHASES = 13;
struct Args { const float* in[23]; float* out; unsigned char* ws; int ph_lo, ph_hi; };
__global__ void __launch_bounds__(512, 2) mk_fwd(Args args) {
    extern __shared__ __attribute__((aligned(16))) unsigned char lds_raw[];
    Ctx F;
    F.lds = (LAS unsigned char*)lds_raw;
    F.tid = threadIdx.x; F.lane = F.tid & 63; F.wave = __builtin_amdgcn_readfirstlane(F.tid >> 6); F.G = gridDim.x;
    F.x = args.in[0]; F.c = args.in[1]; F.ctx = args.in[2]; F.c_ctx = args.in[3]; F.w_ada = args.in[4]; F.b_ada = args.in[5]; F.w_in = args.in[6]; F.w_gate_up = args.in[7]; F.b_gate = args.in[8];
    F.attn_sink = args.in[9]; F.gla_norm_w = args.in[10]; F.w_out = args.in[11]; F.ln1_g = args.in[12]; F.ln1_b = args.in[13]; F.w_rg = args.in[14]; F.b_rg = args.in[15]; F.w_re = args.in[16]; F.b_re = args.in[17];
    F.w_eg = args.in[18]; F.w_eu = args.in[19]; F.w_ed = args.in[20]; F.ln2_g = args.in[21]; F.ln2_b = args.in[22];
    F.out = args.out; F.ws = args.ws;
    volatile LAS unsigned* MISC = (volatile LAS unsigned*)(F.lds + MISC_OFF);
    if (F.tid < 64) MISC[F.tid] = 0u;
    __syncthreads();
    unsigned* ctl = (unsigned*)(F.ws + WS_CTL);
    XcdBarrier bar; bar.bar = ctl + CW_BAR; bar.x = 0; bar.st = nullptr;
    if (MK_N_LAUNCHES == 1) bar = xcd_barrier_post(ctl + CW_BAR, MISC + 8);
    const int lo = args.ph_lo, hi = args.ph_hi;
#define IN(k) (lo <= (k) && (k) < hi)
#define SEAM(k) do { if (IN(k) && IN((k) + 1)) xcd_barrier(bar); } while (0)

#ifndef PROBE_PHASE
#define PROBE_PHASE (-1)
#endif
#define REPS(k) (((k) == PROBE_PHASE) ? 2 : 1)
#define PHASE_BODY(...) do { { int _tz = threadIdx.x; asm volatile("" : "+v"(_tz)); F.tid = _tz; F.lane = _tz & 63; F.wave = __builtin_amdgcn_readfirstlane(_tz >> 6); } __VA_ARGS__; } while (0)
#define PHASE(k, ...) do { if (IN(k)) { PHASE_BODY(__VA_ARGS__); if ((k) == PROBE_PHASE) { xcd_barrier(bar); PHASE_BODY(__VA_ARGS__); } } SEAM(k); } while (0)
    PHASE(0, p0_prologue(F));
    PHASE(1, p1_modreduce(F));
    PHASE(2, p2_router_tables(F); p2_modulate(F));
    PHASE(3, {
        p3_gate(F);
        {
            pg8::Gemm g{WSP(bf16, WS_H8), WSP(bf16, WS_WIN), TA, C_RB, DM / 2, 0}; pg8::StaticOrder S; S.init(TA, C_RB, F.G, (int)blockIdx.x);
            EpiProj E{WSP(bf16, WS_R1), WSP(float, WS_ROPE), W8_INV};
            pg8::gemm_phase<EpiProj, pg8::StaticOrder, true, true, true>(F.lds, g, S, E); }
        {
            pg8::Gemm g{WSP(bf16, WS_R2), WSP(bf16, WS_WINR), T, 1024, DM, 0}; pg8::StaticOrder S; S.init(T, 1024, F.G, (int)blockIdx.x);
            EpiCols E{WSP(bf16, WS_R1), NPRJ, C_RB};
            pg8::gemm_phase<EpiCols, pg8::StaticOrder, true, true>(F.lds, g, S, E); }
        if (F.G == 256 && blockIdx.x >= 200) xp_convert(F, XP_N0, XP_N0 + XP_N3, (int)blockIdx.x - 200, 56);
    });
    PHASE(4, {
        for (int u = blockIdx.x; u < 512; u += F.G) attn_unit(F, u);
        for (int u = blockIdx.x; u < 256; u += F.G) gla_passA_wide(F, u);
        if (F.G == 256 && (blockIdx.x & 3) == 0) xp_convert(F, XP_N0 + XP_N3, XP_ITEMS, (int)blockIdx.x >> 2, 64);
    });
    PHASE(5, { for (int u = blockIdx.x; u < 256; u += F.G) gla_passC_wide(F, u); });
    PHASE(6, p6_gla_out(F));
    PHASE(7, {
        pg8::Gemm g{WSP(bf16, WS_MIX), WSP(bf16, WS_WOUT), T, DM, DM / 2, 0}; pg8::StaticOrder S; S.init(T, DM, F.G, (int)blockIdx.x);
        EpiX1 E{F.x, WSP(float, WS_MOD), WSP(bf16, WS_X1), W8_INV};
        pg8::gemm_phase<EpiX1, pg8::StaticOrder, true, true, true>(F.lds, g, S, E);
    });
#ifdef PROBE_P8
    if (IN(8)) { PHASE_BODY(p8_ln_route<true>(F)); xcd_barrier(bar); }
#endif
    PHASE(8, p8_ln_route<false>(F));
    PHASE(9, p9_gather(F));
    if (IN(10) || IN(11)) {
        const int* meta = WSP(int, TOK_META); LAS int* tl = (LAS int*)(F.lds + TILE_OFF);
        const int tt = threadIdx.x; if (tt <= MAXTILES) tl[tt] = meta[tt];
        __syncthreads();
    }
    PHASE(10, {
        const LAS int* tl = (const LAS int*)(F.lds + TILE_OFF); const int ntl = __builtin_amdgcn_readfirstlane(tl[0]);
        pg8::Gemm g{WSP(bf16, WS_R2), WSP(bf16, WS_WGU), ntl * 256, DM, DM / 2, (size_t)DM * DM};
        MoeOrderG S; S.nM = ntl; S.nN = 8; S.nwg = ntl * 8; S.G = F.G; S.c = (int)blockIdx.x; S.tile_e = tl + 1;
        {
            LAS int* rt = (LAS int*)(F.lds + TILE_OFF + 1024); const int* perm = WSP(int, TOK_PERM); const int tt = threadIdx.x; pg8::Unit u;
            for (int i = 0; i < MOE_MAXUNITS && S.next(i, u); ++i) if (tt < 256) rt[i * 256 + tt] = perm[256 * u.pm + tt] << 11;
            __syncthreads(); S.rows = rt; }
        EpiSwiGLU E{WSP(unsigned char, WS_R1)};
        pg8::gemm_phase<EpiSwiGLU, MoeOrderG, true, true, true>(F.lds, g, S, E);
    });
    PHASE(11, {
        const LAS int* tl = (const LAS int*)(F.lds + TILE_OFF); const int ntl = __builtin_amdgcn_readfirstlane(tl[0]);
        pg8::Gemm g{WSP(bf16, WS_R1), WSP(bf16, WS_WDN), ntl * 256, DM, EH / 2, (size_t)DM * EH};
        MoeOrder S; S.nM = ntl; S.nN = 8; S.nwg = ntl * 8; S.G = F.G; S.c = (int)blockIdx.x; S.tile_e = tl + 1; S.rows = nullptr;
        EpiPlain E{WSP(unsigned char, WS_R2), DM, W8_INV};
        pg8::gemm_phase<EpiPlain, MoeOrder, true, true, true>(F.lds, g, S, E);
    });
    PHASE(12, p12_final(F));
#undef PHASE
#undef REPS
#undef IN
#undef SEAM
}

extern "C" void kernel_launch(void* const* d_in, const int* in_sizes, int n_in, void* d_out, int out_size, void* d_ws, size_t ws_size, hipStream_t stream) {
    static int grid = 0;
    if (grid == 0) {
        if (n_in != 23 || out_size != T * DM || ws_size < WS_END) { fprintf(stderr, "kernel_launch: unexpected problem (n_in %d, out %d, ws %zu < %zu)\n", n_in, out_size, ws_size, (size_t)WS_END); grid = -1; return; }
        int dev = 0, cus = 0, per_cu = 0;
        if (hipGetDevice(&dev) != hipSuccess || hipDeviceGetAttribute(&cus, hipDeviceAttributeMultiprocessorCount, dev) != hipSuccess) { grid = -1; return; }
        if (hipFuncSetAttribute((const void*)mk_fwd, hipFuncAttributeMaxDynamicSharedMemorySize, LDS_BYTES) != hipSuccess) { fprintf(stderr, "kernel_launch: hipFuncSetAttribute failed\n"); grid = -1; return; }
        if (hipOccupancyMaxActiveBlocksPerMultiprocessor(&per_cu, (const void*)mk_fwd, 512, LDS_BYTES) != hipSuccess || per_cu < 1) fprintf(stderr, "kernel_launch: occupancy query reports %d\n", per_cu);
        (void)hipGetLastError();
        grid = cus > 256 ? 256 : cus;
    }
    if (grid < 0) return;
    if (hipMemsetAsync((char*)d_ws + WS_CTL, 0, CTL_ZERO_BYTES, stream) != hipSuccess) return;
    Args a{};
    for (int i = 0; i < 23; ++i) a.in[i] = (const float*)d_in[i];
    a.out = (float*)d_out; a.ws = (unsigned char*)d_ws;
    for (int li = 0; li < MK_N_LAUNCHES; ++li) {
        a.ph_lo = (MK_N_LAUNCHES == 1) ? 0 : li; a.ph_hi = (MK_N_LAUNCHES == 1) ? NPHASES : li + 1;
        hipLaunchKernelGGL(mk_fwd, dim3(grid), dim3(512), LDS_BYTES, stream, a);
    }
}
```

```cpp
#include <hip/hip_runtime.h>
#include <cstdio>
#include <cstdint>

#ifndef MK_N_LAUNCHES
#define MK_N_LAUNCHES 1
#endif

namespace pg8 {
#define PG8_LAS __attribute__((address_space(3)))
typedef unsigned short bf16_t;
typedef short bf16x8 __attribute__((ext_vector_type(8)));
typedef float f32x4 __attribute__((ext_vector_type(4)));
typedef unsigned u32x4 __attribute__((ext_vector_type(4)));
typedef int v4i_t __attribute__((ext_vector_type(4)));
typedef int v8i_t __attribute__((ext_vector_type(8)));
constexpr int BM = 256, BK = 64, HALF = 128, HTB = HALF * BK * 2  , STAGE_BYTES = 8 * HTB, NXCD = 8, WGM = 2;

__host__ __device__ __forceinline__ int lds_byte(int r, int c) { const int st = (r >> 4) * 2 + (c >> 5), rr = r & 15, cc = c & 31, ob = rr * 64 + cc * 2; return st * 1024 + (ob ^ (((ob >> 9) & 1) << 5)); }
__host__ __device__ __forceinline__ void stage_rc(int b, int& R, int& C) { const int st = b / 1024, sb = b % 1024, swz = sb ^ (((sb >> 9) & 1) << 5); R = (st >> 1) * 16 + swz / 64; C = (st & 1) * 32 + (swz % 64) / 2; }
__host__ __device__ __forceinline__ int perm32(int rho) { const int n = rho >> 4, i = rho & 15; return 8 * (i >> 2) + 4 * n + (i & 3); }

struct Unit { int pm, pn, e; };
struct Gemm { const bf16_t* A; const bf16_t* Bt; int M, N, K; size_t bstride; };

struct StaticOrder {
    static constexpr bool GATHER = false;
    int nM, nN, nwg, G, c, wgm;
    __host__ __device__ void init(int M, int N, int G_, int c_, int wgm_ = WGM) { nM = M / BM; nN = N / BM; nwg = nM * nN; G = G_; c = c_; wgm = wgm_; }
    __host__ __device__ bool next(int i, Unit& u) const {
        const long L = (long)i * G + c; if (L >= nwg) return false;
        int wgid = (int)L; { const int q = nwg / NXCD, r = nwg % NXCD, xcd = wgid % NXCD, off = wgid / NXCD; wgid = (xcd < r ? xcd * (q + 1) : r * (q + 1) + (xcd - r) * q) + off; }
        const int nig = wgm * nN, gid = wgid / nig, fm = gid * wgm, gsz = (nM - fm) < wgm ? (nM - fm) : wgm;
        u.pm = fm + ((wgid % nig) % gsz); u.pn = (wgid % nig) / gsz; u.e = 0; return true;
    }
    __device__ __forceinline__ void a_ready(const Unit&) const {}
    __device__ __forceinline__ void done(const Unit&) const {}
};
__device__ __forceinline__ unsigned cvt_pk_bf16(float lo, float hi) { unsigned r; asm volatile("v_cvt_pk_bf16_f32 %0, %1, %2" : "=v"(r) : "v"(lo), "v"(hi)); return r; }
template <class Epi, class Sched, bool ALIGN_EPI = false, bool SP2 = false, bool FP8 = false>
__device__ __forceinline__ void gemm_phase(PG8_LAS unsigned char* lds, const Gemm g, const Sched& S, const Epi& E) {
    int tzs_ = threadIdx.x; asm volatile("" : "+v"(tzs_));
    const int tid = tzs_, wid = __builtin_amdgcn_readfirstlane(tid >> 6), lane = tid & 63, wr = wid >> 2, wc = wid & 3, fr = lane & 15, fq = lane >> 4;
    const int K = g.K, nt = K / BK;
    unsigned voffA[2], voffB[2];
#pragma unroll
    for (int i = 0; i < 2; ++i) { int R, C; stage_rc(tid * 16 + i * 8192, R, C); const int Rb = Epi::PERM ? ((R & ~31) + perm32(R & 31)) : R;
        voffA[i] = (unsigned)(R * K + C) * 2u; voffB[i] = (unsigned)(Rb * K + C) * 2u; }
    const size_t kstep = (size_t)(BK * 2);
    const size_t hstep = (size_t)HALF * K * 2;
    constexpr bool GATHER = Sched::GATHER; static_assert(!GATHER || SP2, "the row-table re-read sits in front of an lgkmcnt(0) wait only in the SP2 schedule");
    unsigned cv[2][2]; int rA[2]; unsigned cA2[2];
#pragma unroll
    for (int i = 0; i < 2; ++i) { int R, C; stage_rc(tid * 16 + i * 8192, R, C); rA[i] = R; cA2[i] = (unsigned)C * 2u; }
#define PG8_ROWS(dst, ui_) do { if constexpr (GATHER) { _Pragma("unroll") for (int h = 0; h < 2; ++h) _Pragma("unroll") for (int i = 0; i < 2; ++i) dst[h][i] = (unsigned)S.rows[(ui_) * 256 + 128 * h + rA[i]] + cA2[i]; } } while (0)

    const size_t tstep = 2 * hstep;
    const unsigned ldsw = (unsigned)wid * 1024u;
    const int aoff = lds_byte(wr * 64 + fr, fq * 8), boff = lds_byte(wc * 32 + fr, fq * 8);
#define PG8_SA(b, h) (((b) * 2 + (h)) * HTB)
#define PG8_SB(b, h) ((4 + (b) * 2 + (h)) * HTB)
#define PG8_STAGE(bufoff, gbase, voff) do { _Pragma("unroll") for (int _i = 0; _i < 2; ++_i) { unsigned _vo = (voff)[_i]; asm volatile("" : "+v"(_vo));     \
        __builtin_amdgcn_global_load_lds((const unsigned*)((const char*)(gbase) + _vo), (PG8_LAS unsigned*)(lds + (bufoff) + ldsw + _i * 8192), 16, 0, 0); } } while (0)
#define PG8_STAGE_A(bufoff, gbase, h, sel) do { if constexpr (GATHER) { _Pragma("unroll") for (int _i = 0; _i < 2; ++_i) { unsigned _vo = cv[h][_i]; asm volatile("" : "+v"(_vo)); \
        __builtin_amdgcn_global_load_lds((const unsigned*)((const char*)(gbase) + _vo), (PG8_LAS unsigned*)(lds + (bufoff) + ldsw + _i * 8192), 16, 0, 0); } } \
        else PG8_STAGE(bufoff, (gbase) + (h) * hstep, voffA); } while (0)
#define PG8_LDA(dst, b, h) do { _Pragma("unroll") for (int m = 0; m < 4; ++m) { \
        if constexpr (FP8) dst##8[m] = __builtin_shufflevector(*(const PG8_LAS v4i_t*)(lds + PG8_SA(b, h) + aoff + m * 2048), *(const PG8_LAS v4i_t*)(lds + PG8_SA(b, h) + aoff + m * 2048 + 1024), 0, 1, 2, 3, 4, 5, 6, 7); \
        else { _Pragma("unroll") for (int k = 0; k < 2; ++k) dst[m][k] = *(const PG8_LAS bf16x8*)(lds + PG8_SA(b, h) + aoff + m * 2048 + k * 1024); } } } while (0)
#define PG8_LDB(dst, b, h) do { _Pragma("unroll") for (int n = 0; n < 2; ++n) { \
        if constexpr (FP8) dst##8[n] = __builtin_shufflevector(*(const PG8_LAS v4i_t*)(lds + PG8_SB(b, h) + boff + n * 2048), *(const PG8_LAS v4i_t*)(lds + PG8_SB(b, h) + boff + n * 2048 + 1024), 0, 1, 2, 3, 4, 5, 6, 7); \
        else { _Pragma("unroll") for (int k = 0; k < 2; ++k) dst[n][k] = *(const PG8_LAS bf16x8*)(lds + PG8_SB(b, h) + boff + n * 2048 + k * 1024); } } } while (0)
#define PG8_MMA(ai, bj, At, Bt) do { __builtin_amdgcn_s_setprio(1); _Pragma("unroll") for (int m = 0; m < 4; ++m) _Pragma("unroll") for (int n = 0; n < 2; ++n) { \
        if constexpr (FP8) acc[ai][bj][m][n] = __builtin_amdgcn_mfma_scale_f32_16x16x128_f8f6f4(Bt##8[n], At##8[m], acc[ai][bj][m][n], 0, 0, 0, 0x7f7f7f7f, 0, 0x7f7f7f7f); \
        else { _Pragma("unroll") for (int k = 0; k < 2; ++k) acc[ai][bj][m][n] = __builtin_amdgcn_mfma_f32_16x16x32_bf16(Bt[n][k], At[m][k], acc[ai][bj][m][n], 0, 0, 0); } } __builtin_amdgcn_s_setprio(0); } while (0)
#define PG8_WAIT_V(n) asm volatile("s_waitcnt vmcnt(" #n ")" ::: "memory")
#define PG8_WAIT_L(n) asm volatile("s_waitcnt lgkmcnt(" #n ")" ::: "memory")
#define PG8_BAR __builtin_amdgcn_s_barrier()
#define PG8_SCHED __builtin_amdgcn_sched_barrier(0)
    Unit cur, nxt; int ui = 0;
    if (!S.next(0, cur)) return;
    f32x4 acc[2][2][4][2];
#pragma unroll
    for (int a = 0; a < 2; ++a)
#pragma unroll
        for (int b = 0; b < 2; ++b)
#pragma unroll
            for (int m = 0; m < 4; ++m)
#pragma unroll
                for (int n = 0; n < 2; ++n) acc[a][b][m][n] = (f32x4){0.f, 0.f, 0.f, 0.f};
    bf16x8 At[4][2], B0[2][2], B1[2][2]; v8i_t At8[4], B08[2], B18[2];
    const char* cA = (const char*)g.A + (GATHER ? (size_t)0 : (size_t)cur.pm * tstep); const char* cB = (const char*)g.Bt + (size_t)cur.e * g.bstride + (size_t)cur.pn * tstep;
    S.a_ready(cur);
    PG8_ROWS(cv, 0);
    if constexpr (SP2) {
        PG8_STAGE(PG8_SB(0, 0), cB, voffB); PG8_STAGE(PG8_SB(0, 1), cB + hstep, voffB); PG8_STAGE_A(PG8_SA(0, 0), cA, 0, false); PG8_STAGE_A(PG8_SA(0, 1), cA, 1, false);
        if (wr == 1) PG8_BAR;
        PG8_WAIT_V(2); PG8_BAR;
        PG8_STAGE(PG8_SB(1, 0), cB + kstep, voffB); PG8_STAGE_A(PG8_SA(1, 0), cA + kstep, 0, false); PG8_STAGE(PG8_SB(1, 1), cB + hstep + kstep, voffB);
        PG8_WAIT_V(6); PG8_BAR;
    } else {
        PG8_STAGE(PG8_SB(0, 0), cB, voffB); PG8_STAGE_A(PG8_SA(0, 0), cA, 0, false); PG8_STAGE(PG8_SB(0, 1), cB + hstep, voffB); PG8_STAGE_A(PG8_SA(0, 1), cA, 1, false);
        if (wr == 1) PG8_BAR;
        PG8_WAIT_V(4); PG8_BAR;
        PG8_STAGE(PG8_SB(1, 0), cB + kstep, voffB); PG8_STAGE_A(PG8_SA(1, 0), cA + kstep, 0, false); PG8_STAGE(PG8_SB(1, 1), cB + hstep + kstep, voffB);
        PG8_WAIT_V(6); PG8_BAR;
    }
    for (;;) {
        const bool has_next = S.next(ui + 1, nxt);
        const char* nA = has_next ? (const char*)g.A + (GATHER ? (size_t)0 : (size_t)nxt.pm * tstep) : cA; const char* nB = has_next ? (const char*)g.Bt + (size_t)nxt.e * g.bstride + (size_t)nxt.pn * tstep : cB;
#pragma nounroll
        for (int t = 0; t < nt; t += 2) {
            const bool last = (t == nt - 2);
            const char* a1 = cA + (size_t)(t + 1) * kstep;
            const char* a2 = last ? nA : cA + (size_t)(t + 2) * kstep; const char* b2 = last ? nB : cB + (size_t)(t + 2) * kstep;
            const char* a3 = a2 + kstep; const char* b3 = b2 + kstep;
            if (last && has_next) S.a_ready(nxt);
            if constexpr (SP2) {
            PG8_LDB(B0, 0, 0); PG8_LDB(B1, 0, 1); PG8_SCHED; PG8_LDA(At, 0, 0); PG8_STAGE_A(PG8_SA(1, 1), a1, 1, false);
            if constexpr (GATHER) { if (last && has_next) PG8_ROWS(cv, ui + 1); }
            PG8_WAIT_V(8); PG8_WAIT_L(0); PG8_BAR; PG8_MMA(0, 0, At, B0); PG8_MMA(0, 1, At, B1); PG8_BAR; PG8_SCHED;
            PG8_LDA(At, 0, 1); PG8_STAGE(PG8_SB(0, 0), b2, voffB); PG8_STAGE(PG8_SB(0, 1), b2 + hstep, voffB); PG8_STAGE_A(PG8_SA(0, 0), a2, 0, last);
            PG8_WAIT_V(8); PG8_WAIT_L(0); PG8_BAR; PG8_MMA(1, 0, At, B0); PG8_MMA(1, 1, At, B1); PG8_BAR; PG8_SCHED;
            PG8_LDB(B0, 1, 0); PG8_LDB(B1, 1, 1); PG8_SCHED; PG8_LDA(At, 1, 0); PG8_STAGE_A(PG8_SA(0, 1), a2, 1, last);
            PG8_WAIT_V(8); PG8_WAIT_L(0); PG8_BAR; PG8_MMA(0, 0, At, B0); PG8_MMA(0, 1, At, B1); PG8_BAR; PG8_SCHED;
            PG8_LDA(At, 1, 1); PG8_STAGE(PG8_SB(1, 0), b3, voffB); PG8_STAGE(PG8_SB(1, 1), b3 + hstep, voffB); PG8_STAGE_A(PG8_SA(1, 0), a3, 0, last);
            PG8_WAIT_V(8); PG8_WAIT_L(0); PG8_BAR; PG8_MMA(1, 0, At, B0); PG8_MMA(1, 1, At, B1); PG8_BAR; PG8_SCHED;
            } else {
            PG8_LDB(B0, 0, 0); PG8_SCHED; PG8_LDA(At, 0, 0); PG8_STAGE_A(PG8_SA(1, 1), a1, 1, false);
            if constexpr (GATHER) { if (last && has_next) PG8_ROWS(cv, ui + 1); }
            PG8_WAIT_L(8); PG8_BAR; PG8_WAIT_L(0); PG8_MMA(0, 0, At, B0); PG8_BAR; PG8_SCHED;
            PG8_LDB(B1, 0, 1); PG8_STAGE(PG8_SB(0, 0), b2, voffB);
            PG8_BAR; PG8_WAIT_L(0); PG8_MMA(0, 1, At, B1); PG8_BAR;
            PG8_LDA(At, 0, 1); PG8_STAGE_A(PG8_SA(0, 0), a2, 0, last);
            PG8_BAR; PG8_WAIT_L(0); PG8_MMA(1, 0, At, B0); PG8_BAR; PG8_SCHED;
            PG8_STAGE(PG8_SB(0, 1), b2 + hstep, voffB);
            PG8_WAIT_V(6); PG8_BAR; PG8_MMA(1, 1, At, B1); PG8_BAR;
            PG8_LDB(B0, 1, 0); PG8_SCHED; PG8_LDA(At, 1, 0); PG8_STAGE_A(PG8_SA(0, 1), a2, 1, last);
            PG8_WAIT_L(8); PG8_BAR; PG8_WAIT_L(0); PG8_MMA(0, 0, At, B0); PG8_BAR; PG8_SCHED;
            PG8_LDB(B1, 1, 1); PG8_STAGE(PG8_SB(1, 0), b3, voffB);
            PG8_BAR; PG8_WAIT_L(0); PG8_MMA(0, 1, At, B1); PG8_BAR;
            PG8_LDA(At, 1, 1); PG8_STAGE_A(PG8_SA(1, 0), a3, 0, last);
            PG8_BAR; PG8_WAIT_L(0); PG8_MMA(1, 0, At, B0); PG8_BAR; PG8_SCHED;
            PG8_STAGE(PG8_SB(1, 1), b3 + hstep, voffB);
            PG8_WAIT_V(6); PG8_BAR; PG8_MMA(1, 1, At, B1); PG8_BAR;
            }
        }
        if constexpr (ALIGN_EPI) { if (wr == 0) PG8_BAR; }
        if constexpr (!Epi::AFTER_DRAIN) { int tz_ = threadIdx.x; asm volatile("" : "+v"(tz_));
            const int l2_ = tz_ & 63; E(acc, cur, wr, wc, l2_ & 15, l2_ >> 4); S.done(cur); }
        if (!has_next) break;
#pragma unroll
        for (int a = 0; a < 2; ++a)
#pragma unroll
            for (int b = 0; b < 2; ++b)
#pragma unroll
                for (int m = 0; m < 4; ++m)
#pragma unroll
                    for (int n = 0; n < 2; ++n) acc[a][b][m][n] = (f32x4){0.f, 0.f, 0.f, 0.f};
        cur = nxt; cA = nA; cB = nB; ++ui;
        if constexpr (ALIGN_EPI) { if (wr == 1) PG8_BAR; }
    }
    PG8_WAIT_V(0);
    if constexpr (!ALIGN_EPI) { if (wr == 0) PG8_BAR; }
    PG8_BAR;
    if constexpr (Epi::AFTER_DRAIN) { E.fused(acc, cur, wr, wc, fr, fq, lds, wid, lane); S.done(cur); }
#undef PG8_SA
#undef PG8_SB
#undef PG8_STAGE
#undef PG8_STAGE_A
#undef PG8_ROWS
#undef PG8_LDA
#undef PG8_LDB
#undef PG8_MMA
#undef PG8_WAIT_V
#undef PG8_WAIT_L
#undef PG8_BAR
#undef PG8_SCHED
}
}

constexpr int DM = 2048, NB = 4, SEQ = 4096, T = NB * SEQ, CL = 256, TC = NB * CL, TA = T + TC;
constexpr int NPRJ = 4608;
constexpr int C_QA = 0, C_KA = 1024, C_VA = 1280, C_QB = 1536, C_KB = 2048, C_VB = 2560, C_RB = 3584, C_GB = 4608, INW = 4640;
constexpr int NE = 32, EH = 1024, NMOD = 6 * DM;
constexpr float ALPHA = 1.189207115002721f, LN_EPS = 1e-6f;
constexpr int MOE_MAXUNITS = 12;
constexpr int MAXTILES = 160;

constexpr size_t MiB = 1u << 20;
constexpr size_t WS_CTL = 0, CTL_ZERO_BYTES = 1 * MiB;
constexpr size_t WS_MODP = 1 * MiB;
constexpr size_t WS_WQH = 1 * MiB, WS_WQL = 2 * MiB, WS_UV = 3 * MiB;
constexpr size_t WS_MOD = 9 * MiB;
constexpr size_t WS_ROPE = 9 * MiB + 256 * 1024;
constexpr size_t WS_WG = 9 * MiB + 896 * 1024;
constexpr size_t WS_TOK = 10 * MiB;
constexpr size_t TOK_E = WS_TOK, TOK_RANK = WS_TOK + 131072, TOK_W = WS_TOK + 262144, TOK_SLOT = WS_TOK + 393216, TOK_CNT = WS_TOK + 524288, TOK_META = WS_TOK + 557056, TOK_ROWST = WS_TOK + 655360, TOK_PERM = WS_TOK + 786432;
constexpr size_t WS_GB = 11 * MiB;
constexpr size_t WS_WIN = 14 * MiB, WS_WINR = 22 * MiB;
constexpr size_t WS_WOUT = 32 * MiB;
constexpr size_t WS_WGU = 40 * MiB;
constexpr size_t WS_WDN = 296 * MiB;
constexpr size_t WS_R1 = 424 * MiB;
constexpr size_t WS_R2 = 584 * MiB;
constexpr size_t WS_H8 = WS_R2 + 70 * MiB;
constexpr size_t WS_MIX = 712 * MiB;
constexpr size_t WS_GL = 860 * MiB;
constexpr size_t WS_GLD = 792 * MiB;
constexpr size_t WS_X1 = 794 * MiB;
constexpr size_t WS_END = 922 * MiB;
constexpr int CW_TMO = 0, CW_BAR = 4096, CW_GEMV = 8192;

constexpr int RING_BYTES = 131072, MISC_OFF = RING_BYTES, TILE_OFF = RING_BYTES + 256, LDS_BYTES = 147456;

#define GAS __attribute__((address_space(1)))
#define LAS __attribute__((address_space(3)))
typedef unsigned short bf16;
typedef unsigned v4u __attribute__((ext_vector_type(4)));
typedef unsigned v2u __attribute__((ext_vector_type(2)));
typedef float f32x4 __attribute__((ext_vector_type(4)));
typedef float f32x2 __attribute__((ext_vector_type(2)));
typedef short bf16x8 __attribute__((ext_vector_type(8)));
typedef short bf16x4 __attribute__((ext_vector_type(4)));
#define LDS_WAIT() asm volatile("s_waitcnt lgkmcnt(0)" ::: "memory")
#define VM_WAIT() asm volatile("s_waitcnt vmcnt(0)" ::: "memory")
typedef __bf16 bf16v2_t __attribute__((ext_vector_type(2)));
__device__ __forceinline__ unsigned f2bf(float f) { return (unsigned)__builtin_bit_cast(unsigned short, (__bf16)f); }
__device__ __forceinline__ unsigned pk2(float lo, float hi) { bf16v2_t v = {(__bf16)lo, (__bf16)hi}; return __builtin_bit_cast(unsigned, v); }
__device__ __forceinline__ float clamp_fp8(float v) { return __builtin_amdgcn_fmed3f(v, -448.f, 448.f); }
__device__ __forceinline__ unsigned pk4_fp8(float a, float b, float c, float d) {
    int w = 0; w = __builtin_amdgcn_cvt_pk_fp8_f32(clamp_fp8(a), clamp_fp8(b), w, false); w = __builtin_amdgcn_cvt_pk_fp8_f32(clamp_fp8(c), clamp_fp8(d), w, true); return (unsigned)w; }
constexpr float W8_SCALE = 64.f, W8_INV = 1.f / 64.f;
__device__ __forceinline__ float bf2f(unsigned h) { return __builtin_bit_cast(float, h << 16); }
__device__ __forceinline__ float wave_sum(float v) {
#pragma unroll
    for (int o = 1; o < 64; o <<= 1) v += __shfl_xor(v, o);
    return v;
}
__device__ __forceinline__ float silu_f(float v) { return v * __builtin_amdgcn_rcpf(1.f + __builtin_amdgcn_exp2f(v * -1.4426950408889634f)); }

#define XB_TMO      128
#define XB_XCNT(j)  (256  + 64 * (j))
#define XB_XSUB(j)  (1280 + 64 * (j))
#define XB_XGEN(j)  (2304 + 64 * (j))
#define XB_TOP      3328
#define XB_TOPGEN   3392
#define XCD_BAR_WORDS 3456
#define XB_SPIN_CAP (1u << 18)
__device__ __forceinline__ unsigned xb_ld(unsigned* p)              { return __hip_atomic_load(p, __ATOMIC_RELAXED, __HIP_MEMORY_SCOPE_AGENT); }
__device__ __forceinline__ unsigned xb_add(unsigned* p, unsigned v) { return __hip_atomic_fetch_add(p, v, __ATOMIC_RELAXED, __HIP_MEMORY_SCOPE_AGENT); }
__device__ __forceinline__ unsigned xb_xcc_id() { return (unsigned)__builtin_amdgcn_s_getreg((3 << 11) | 20) & 0xFu; }
#define XB_SPIN(cond, bar) do { unsigned _sp = 0; while (cond) { __builtin_amdgcn_s_sleep(1); \
    if ((++_sp & 255u) == 0u) { if (xb_ld(&(bar)[XB_TMO])) break; if (_sp > XB_SPIN_CAP) { atomicAdd(&(bar)[XB_TMO], 1u); break; } } } } while (0)
struct XcdBarrier { unsigned* bar; unsigned x; volatile LAS unsigned* st; };
__device__ __forceinline__ XcdBarrier xcd_barrier_post(unsigned* bar, volatile LAS unsigned* st) {
    XcdBarrier b; b.bar = bar; b.x = xb_xcc_id(); b.st = st;
    if (threadIdx.x == 0) (void)xb_add(&bar[XB_XCNT(b.x)], 1u);
    return b;
}
__device__ __forceinline__ void xcd_barrier_complete(unsigned* bar, unsigned x, unsigned& nloc, unsigned& nx) {
    const unsigned G = gridDim.x * gridDim.y * gridDim.z;
    unsigned sum, cnt, mine, sp = 0u;
    for (;;) {
        sum = 0u; cnt = 0u; mine = 0u;
#pragma unroll
        for (unsigned j = 0; j < 16; ++j) { const unsigned c = xb_ld(&bar[XB_XCNT(j)]); sum += c; cnt += (c > 0u) ? 1u : 0u; mine = (j == x) ? c : mine; }
        if (sum == G) break;
        __builtin_amdgcn_s_sleep(1);
        if ((++sp & 255u) == 0u) { if (xb_ld(&bar[XB_TMO])) break; if (sp > XB_SPIN_CAP) { atomicAdd(&bar[XB_TMO], 1u); break; } }
    }
    nloc = mine > 0u ? mine : 1u; nx = cnt > 0u ? cnt : 1u;
}
__device__ __forceinline__ void xcd_barrier(const XcdBarrier& b) {
    asm volatile("s_waitcnt vmcnt(0)" ::: "memory");
    __syncthreads();
    if (threadIdx.x == 0) {
        unsigned* bar = b.bar;
        __builtin_amdgcn_s_waitcnt(0);
        unsigned nloc = b.st[0], nx = b.st[1];
        if (nloc == 0u) { xcd_barrier_complete(bar, b.x, nloc, nx); b.st[0] = nloc; b.st[1] = nx; }
        const unsigned old = xb_add(&bar[XB_XSUB(b.x)], 1u);
        const unsigned gen = old / nloc;
        if (old + 1u == (gen + 1u) * nloc) {
            __builtin_amdgcn_fence(__ATOMIC_RELEASE, "agent");
            asm volatile("s_waitcnt vmcnt(0)" ::: "memory");
            const unsigned og = xb_add(&bar[XB_TOP], 1u);
            const unsigned tg = og / nx;
            if (og + 1u == (tg + 1u) * nx) xb_add(&bar[XB_TOPGEN], 1u);
            else XB_SPIN(xb_ld(&bar[XB_TOPGEN]) == tg, bar);
            __builtin_amdgcn_fence(__ATOMIC_ACQUIRE, "agent");
            xb_add(&bar[XB_XGEN(b.x)], 1u);
            asm volatile("s_waitcnt vmcnt(0)" ::: "memory");
        } else {
            XB_SPIN(xb_ld(&bar[XB_XGEN(b.x)]) == gen, bar);
            __builtin_amdgcn_fence(__ATOMIC_ACQUIRE, "agent");
            asm volatile("s_waitcnt vmcnt(0)" ::: "memory");
        }
    }
    __syncthreads();
}

struct Ctx {
    LAS unsigned char* lds;
    int tid, lane, wave, G;
    const float *x, *c, *ctx, *c_ctx, *w_ada, *b_ada, *w_in, *w_gate_up, *b_gate, *attn_sink, *gla_norm_w, *w_out, *ln1_g, *ln1_b,
                *w_rg, *b_rg, *w_re, *b_re, *w_eg, *w_eu, *w_ed, *ln2_g, *ln2_b;
    float* out; unsigned char* ws;
};
#define WSP(T_, off) ((T_*)(F.ws + (off)))

template <class SrcCol>
__device__ __forceinline__ void transpose_item(const SrcCol& sc, size_t ldw, int K, bf16* WT, int n0, int k0, LAS float* scr, int lane) {
    const float* colp = sc(n0 + (lane & 31));
    float v[32];
#pragma unroll
    for (int i = 0; i < 32; ++i) v[i] = *(const GAS float*)(colp + (size_t)(k0 + 2 * i + (lane >> 5)) * ldw);
#pragma unroll
    for (int i = 0; i < 32; ++i) scr[(2 * i + (lane >> 5)) * 33 + (lane & 31)] = v[i];
    LDS_WAIT(); asm volatile("" ::: "memory");
    const int c = lane & 7;
#pragma unroll
    for (int j = 0; j < 4; ++j) { const int n = (lane >> 3) + 8 * j; const LAS float* s = scr + (8 * c) * 33 + n;
        v4u o; o.x = pk2(s[0 * 33], s[1 * 33]); o.y = pk2(s[2 * 33], s[3 * 33]); o.z = pk2(s[4 * 33], s[5 * 33]); o.w = pk2(s[6 * 33], s[7 * 33]);
        *(GAS v4u*)(WT + (size_t)(n0 + n) * K + k0 + 8 * c) = o; }
    LDS_WAIT(); asm volatile("" ::: "memory");
}
template <class SrcCol>
__device__ __forceinline__ void transpose_item_fp8(const SrcCol& sc, size_t ldw, int K, unsigned char* WT, int n0, int k0, LAS float* scr, int lane) {
    const float* colp = sc(n0 + (lane & 31));
    float v[32];
#pragma unroll
    for (int i = 0; i < 32; ++i) v[i] = *(const GAS float*)(colp + (size_t)(k0 + 2 * i + (lane >> 5)) * ldw);
#pragma unroll
    for (int i = 0; i < 32; ++i) scr[(2 * i + (lane >> 5)) * 33 + (lane & 31)] = v[i] * W8_SCALE;
    LDS_WAIT(); asm volatile("" ::: "memory");
    const int c = lane & 7;
#pragma unroll
    for (int j = 0; j < 4; ++j) { const int n = (lane >> 3) + 8 * j; const LAS float* s = scr + (8 * c) * 33 + n;
        v2u o; o.x = pk4_fp8(s[0 * 33], s[1 * 33], s[2 * 33], s[3 * 33]); o.y = pk4_fp8(s[4 * 33], s[5 * 33], s[6 * 33], s[7 * 33]);
        *(GAS v2u*)(WT + (size_t)(n0 + n) * K + k0 + 8 * c) = o; }
    LDS_WAIT(); asm volatile("" ::: "memory");
}
__device__ __forceinline__ int rope_sigma(int p) { const int q = (p >> 3) * 4 + (p & 3), n = (p >> 2) & 1; return (q >> 5) * 64 + n * 32 + (q & 31); }
struct SrcWin { const float* w; __device__ __forceinline__ const float* operator()(int j) const { int col = j; if (j < C_VA) col = (j & ~127) + rope_sigma(j & 127); return w + col; } };
struct SrcPlain { const float* w; __device__ __forceinline__ const float* operator()(int j) const { return w + j; } };
struct SrcGU { const float* wg; long long du; __device__ __forceinline__ const float* operator()(int j) const { const int pn = j >> 8, jj = j & 127; return wg + (long long)((j >> 7) & 1) * du + pn * 128 + jj; } };

constexpr int XP_ITEMS = NE * 192, XP_N3 = 0, XP_N4 = 0,
    XP_N0 = XP_ITEMS - XP_N3 - XP_N4;
__device__ __forceinline__ void xp_convert(Ctx& F, int it_begin, int it_end, int rank, int nranks) {
    const int tid = threadIdx.x;
    LAS float* tl = (LAS float*)F.lds;
    const long long off_up = (long long)(F.w_eu - F.w_eg), off_dn = (long long)(F.w_ed - F.w_eg);
#define XP_SRC(it_, W_, ldw_, k0_, c0_, kind_) const int e_##W_ = (it_) / 192, q_##W_ = (it_) % 192, kind_ = q_##W_ >> 6, r_##W_ = q_##W_ & 63; \
        const float* W_ = F.w_eg + ((kind_ == 0 ? 0ll : kind_ == 1 ? off_up : off_dn) + (long long)e_##W_ * DM * EH); \
        const size_t ldw_ = kind_ < 2 ? EH : DM; const int k0_ = kind_ < 2 ? (r_##W_ >> 2) * 128 : (r_##W_ >> 3) * 128, c0_ = kind_ < 2 ? (r_##W_ & 3) * 256 : (r_##W_ & 7) * 256;
    f32x4 v[16];
    if (it_begin + rank < it_end) { XP_SRC(it_begin + rank, W, ldw, k0, c0, kind); (void)kind;
#pragma unroll
        for (int i = 0; i < 16; ++i) v[i] = *(const GAS f32x4*)(W + (size_t)(k0 + (tid >> 6) + 8 * i) * ldw + c0 + 4 * (tid & 63)); }
    for (int it = it_begin + rank; it < it_end; it += nranks) {
        XP_SRC(it, Wc, ldwc, k0, c0, kind); (void)Wc; (void)ldwc;
        const int e = it / 192;
        const int Kb = kind < 2 ? DM : EH;
        unsigned char* D = F.ws + (kind < 2 ? WS_WGU + (size_t)e * DM * DM : WS_WDN + (size_t)e * DM * EH);
        __syncthreads();
#pragma unroll
        for (int i = 0; i < 16; ++i) *(LAS f32x4*)(tl + ((tid >> 6) + 8 * i) * 256 + 4 * (tid & 63)) = v[i] * W8_SCALE;
        __syncthreads();
        if (it + nranks < it_end) { XP_SRC(it + nranks, W2, ldw2, k02, c02, kind2); (void)kind2;
#pragma unroll
            for (int i = 0; i < 16; ++i) v[i] = *(const GAS f32x4*)(W2 + (size_t)(k02 + (tid >> 6) + 8 * i) * ldw2 + c02 + 4 * (tid & 63)); }
        const int nl = tid & 255, kh = tid >> 8;
        const int c = c0 + nl;
        const int drow = kind < 2 ? ((c >> 7) * 256 + kind * 128 + (c & 127)) : c;
        unsigned char* dp = D + (size_t)drow * Kb + k0 + 64 * kh;
        const LAS float* tc = tl + (64 * kh) * 256 + nl;
#pragma unroll
        for (int j = 0; j < 4; ++j) { v4u o;
            o.x = pk4_fp8(tc[(16 * j + 0) * 256], tc[(16 * j + 1) * 256], tc[(16 * j + 2) * 256], tc[(16 * j + 3) * 256]);
            o.y = pk4_fp8(tc[(16 * j + 4) * 256], tc[(16 * j + 5) * 256], tc[(16 * j + 6) * 256], tc[(16 * j + 7) * 256]);
            o.z = pk4_fp8(tc[(16 * j + 8) * 256], tc[(16 * j + 9) * 256], tc[(16 * j + 10) * 256], tc[(16 * j + 11) * 256]);
            o.w = pk4_fp8(tc[(16 * j + 12) * 256], tc[(16 * j + 13) * 256], tc[(16 * j + 14) * 256], tc[(16 * j + 15) * 256]);
            *(GAS v4u*)(dp + 16 * j) = o; }
    }
#undef XP_SRC
    __syncthreads();
}

__device__ __forceinline__ void p0_prologue(Ctx& F) {
    const int tid = F.tid, lane = F.lane, wave = F.wave, G = F.G;
    {
        LAS float* sil = (LAS float*)(F.lds);
        LAS float* red = (LAS float*)(F.lds + 40960);
        for (int i = tid; i < 5 * DM; i += 512) { const int r = i >> 11, k = i & 2047; const float v = r < 4 ? F.c[r * DM + k] : F.c_ctx[k]; sil[i] = silu_f(v); }
        __syncthreads();
        const int c4 = tid & 127, ks = tid >> 7;
        float* MODP = WSP(float, WS_MODP);
        for (int u = blockIdx.x; u < 768; u += G) {
            const int cg = u % 24, ksl = u / 24, col = cg * 512 + c4 * 4, k0 = ksl * 64 + ks * 16;
            f32x4 acc[5];
#pragma unroll
            for (int r = 0; r < 5; ++r) acc[r] = (f32x4){0.f, 0.f, 0.f, 0.f};
            f32x4 w[16];
#pragma unroll
            for (int i = 0; i < 16; ++i) w[i] = *(const GAS f32x4*)(F.w_ada + (size_t)(k0 + i) * NMOD + col);
#pragma unroll
            for (int i = 0; i < 16; ++i)
#pragma unroll
                for (int r = 0; r < 5; ++r) acc[r] += sil[r * DM + k0 + i] * w[i];
#pragma unroll
            for (int r = 0; r < 5; ++r) *(LAS f32x4*)(red + (ks * 5 + r) * 512 + c4 * 4) = acc[r];
            __syncthreads();
            for (int o = tid; o < 2560; o += 512) { const int r = o >> 9, cc = o & 511;
                MODP[(size_t)(ksl * 5 + r) * NMOD + cg * 512 + cc] = (red[(0 * 5 + r) * 512 + cc] + red[(1 * 5 + r) * 512 + cc]) + (red[(2 * 5 + r) * 512 + cc] + red[(3 * 5 + r) * 512 + cc]); }
            __syncthreads();
        }
    }
    {
        const int gt = blockIdx.x * 512 + tid, NT = G * 512;
        float* rc = WSP(float, WS_ROPE); float* rs = rc + 2048;
        for (int i = gt; i < 2048; i += NT) { const int pos = i >> 5, f = i & 31; const float inv = powf(10000.0f, -(float)f / 32.0f), ang = (float)pos * inv; rc[i] = cosf(ang); rs[i] = sinf(ang); }
    }
    xp_convert(F, 0, F.G == 256 ? XP_N0 : XP_ITEMS, (int)blockIdx.x, G);
#ifdef PROBE_XP
    xp_convert(F, 0, F.G == 256 ? XP_N0 : XP_ITEMS, (int)blockIdx.x, G);
#endif
    {
        LAS float* scr = (LAS float*)(F.lds + wave * 8448);
        const int gw = blockIdx.x * 8 + wave, NGW = G * 8;
        constexpr int I_WIN = 144 * 32, I_WG = 32, I_WOUT = 64 * 32;
        constexpr int NITEMS = I_WIN + I_WG + I_WOUT;
        for (int it = gw; it < NITEMS; it += NGW) {
            int r = it;
            if (r < I_WIN) { SrcWin s{F.w_in}; const int n0 = (r >> 5) * 32, k0 = (r & 31) * 64;
                if (n0 < C_RB) transpose_item_fp8(s, INW, DM, WSP(unsigned char, WS_WIN), n0, k0, scr, lane);
                else { SrcPlain s2{F.w_in + C_RB}; transpose_item(s2, INW, DM, WSP(bf16, WS_WINR), n0 - C_RB, k0, scr, lane); }
                continue; } r -= I_WIN;
            if (r < I_WG) { SrcPlain s{F.w_in + C_GB}; transpose_item(s, INW, DM, WSP(bf16, WS_WG), 0, r * 64, scr, lane); continue; } r -= I_WG;
            { SrcPlain s{F.w_out}; transpose_item_fp8(s, DM, DM, WSP(unsigned char, WS_WOUT), (r >> 5) * 32, (r & 31) * 64, scr, lane); }
        }
    }
}
__device__ __forceinline__ void p1_modreduce(Ctx& F) {
    const float* MODP = WSP(float, WS_MODP); float* MOD = WSP(float, WS_MOD);
    for (int i = blockIdx.x * 512 + F.tid; i < 5 * NMOD; i += F.G * 512) { const int n = i % NMOD; float s = F.b_ada[n];
#pragma unroll 8
        for (int k = 0; k < 32; ++k) s += MODP[(size_t)k * 5 * NMOD + i];
        MOD[i] = s; }
}
__device__ __forceinline__ void p2_router_tables(Ctx& F) {
    const float* MOD = WSP(float, WS_MOD); bf16* WQH = WSP(bf16, WS_WQH); bf16* WQL = WSP(bf16, WS_WQL); float* UV = WSP(float, WS_UV);
    for (int i4 = blockIdx.x * 512 + F.tid; i4 < 4 * 48 * DM / 4; i4 += F.G * 512) { const int i = 4 * i4, b = i / (48 * DM), j = (i >> 11) % 48, k = i & 2047;
        const f32x4 g4 = *(const GAS f32x4*)(F.ln1_g + k), s4 = *(const GAS f32x4*)(MOD + (size_t)b * NMOD + 4 * DM + k); f32x4 w4 = {0.f, 0.f, 0.f, 0.f};
#pragma unroll
        for (int e = 0; e < 4; ++e) { if (j < 4) w4[e] = F.w_rg[(k + e) * 4 + j]; else if (j < 36) w4[e] = F.w_re[(k + e) * 32 + (j - 4)]; }
        const f32x4 wq = w4 * g4 * (s4 + 1.f);
        const unsigned h0 = f2bf(wq[0]), h1 = f2bf(wq[1]), h2 = f2bf(wq[2]), h3 = f2bf(wq[3]);
        v2u oh, ol; oh.x = h0 | (h1 << 16); oh.y = h2 | (h3 << 16); ol.x = pk2(wq[0] - bf2f(h0), wq[1] - bf2f(h1)); ol.y = pk2(wq[2] - bf2f(h2), wq[3] - bf2f(h3));
        *(GAS v2u*)(WQH + i) = oh; *(GAS v2u*)(WQL + i) = ol; }
    if (F.wave == 0) for (int pr = blockIdx.x; pr < 4 * 48; pr += F.G) { const int b = pr / 48, j = pr % 48; const float* mr = MOD + (size_t)b * NMOD; float u0 = 0.f, u1 = 0.f, u2 = 0.f, u3 = 0.f;
        f32x4 g4[8], b4[8], s4[8], h4[8], w4[8];
#pragma unroll
        for (int i = 0; i < 8; ++i) { const int k = 4 * F.lane + 256 * i; g4[i] = *(const GAS f32x4*)(F.ln1_g + k); b4[i] = *(const GAS f32x4*)(F.ln1_b + k); s4[i] = *(const GAS f32x4*)(mr + 4 * DM + k); h4[i] = *(const GAS f32x4*)(mr + 3 * DM + k);
            w4[i] = (f32x4){0.f, 0.f, 0.f, 0.f};
#pragma unroll
            for (int e = 0; e < 4; ++e) { if (j < 4) w4[i][e] = F.w_rg[(k + e) * 4 + j]; else if (j < 36) w4[i][e] = F.w_re[(k + e) * 32 + (j - 4)]; } }
#pragma unroll
        for (int i = 0; i < 8; ++i)
#pragma unroll
            for (int e = 0; e < 4; ++e) { const float w = w4[i][e], sc = 1.f + s4[i][e], wq = w * g4[i][e] * sc; const float hi = bf2f(f2bf(wq)), lo = bf2f(f2bf(wq - hi));
                u0 += hi + lo; u1 += b4[i][e] * sc * w; u2 += sc * w; u3 += h4[i][e] * w; }
        u0 = wave_sum(u0); u1 = wave_sum(u1); u2 = wave_sum(u2); u3 = wave_sum(u3) + (j < 4 ? F.b_rg[j] : j < 36 ? F.b_re[j - 4] : 0.f);
        if (F.lane == 0) { UV[(b * 4 + 0) * 48 + j] = u0; UV[(b * 4 + 1) * 48 + j] = u1; UV[(b * 4 + 2) * 48 + j] = u2; UV[(b * 4 + 3) * 48 + j] = u3; } }
}
__device__ __forceinline__ void p2_modulate(Ctx& F) {
    const float* MOD = WSP(float, WS_MOD); bf16* H = WSP(bf16, WS_R2); unsigned char* H8 = WSP(unsigned char, WS_H8);
    const int gw = blockIdx.x * 8 + F.wave, NGW = F.G * 8, lane = F.lane;
    const bool staged = F.G == 256;
    LAS f32x4* CS = (LAS f32x4*)F.lds;
    int cur_b = -1;
    f32x4 nx[8];
    if (gw < TA) { const float* src = gw < T ? F.x + (size_t)gw * DM : F.ctx + (size_t)(gw - T) * DM;
#pragma unroll
        for (int j = 0; j < 8; ++j) nx[j] = *(const GAS f32x4*)(src + 4 * lane + 256 * j); }
    for (int row = gw; row < TA; row += NGW) {
        const int bidx = row < T ? (row >> 12) : 4;
        const float* mr = MOD + (size_t)bidx * NMOD;
        if (staged && bidx != cur_b) {
            __syncthreads();
            CS[F.tid] = *(const GAS f32x4*)(mr + 4 * F.tid); CS[512 + F.tid] = *(const GAS f32x4*)(mr + DM + 4 * F.tid) + 1.f;
            __syncthreads(); cur_b = bidx; }
        f32x4 v[8]; f32x4 sv = {0.f, 0.f, 0.f, 0.f}, qv = {0.f, 0.f, 0.f, 0.f};
#pragma unroll
        for (int j = 0; j < 8; ++j) { v[j] = nx[j]; sv += v[j]; qv = v[j] * v[j] + qv; }
        const int nrow = row + NGW;
        if (nrow < TA) { const float* src = nrow < T ? F.x + (size_t)nrow * DM : F.ctx + (size_t)(nrow - T) * DM;
#pragma unroll
            for (int j = 0; j < 8; ++j) nx[j] = *(const GAS f32x4*)(src + 4 * lane + 256 * j); }
        const float mean = wave_sum((sv.x + sv.y) + (sv.z + sv.w)) * (1.f / DM), ex2 = wave_sum((qv.x + qv.y) + (qv.z + qv.w)) * (1.f / DM);
        const float rstd = 1.f / sqrtf(fmaxf(ex2 - mean * mean, 0.f) + LN_EPS), nm = -mean * rstd;
#pragma unroll
        for (int j = 0; j < 8; ++j) {
            f32x4 shj, scj;
            if (staged) { shj = CS[lane + 64 * j]; scj = CS[512 + lane + 64 * j]; }
            else { shj = *(const GAS f32x4*)(mr + 4 * lane + 256 * j); scj = *(const GAS f32x4*)(mr + DM + 4 * lane + 256 * j) + 1.f; }
            const f32x4 h = (v[j] * rstd + nm) * scj + shj; v2u o; o.x = pk2(h.x, h.y); o.y = pk2(h.z, h.w);
            *(GAS v2u*)(H + (size_t)row * DM + 4 * lane + 256 * j) = o;
            *(GAS unsigned*)(H8 + (size_t)row * DM + 4 * lane + 256 * j) = pk4_fp8(h.x, h.y, h.z, h.w); }
    }
}


__device__ __forceinline__ void p3_gate(Ctx& F) {
    const bf16* H = WSP(bf16, WS_R2); const bf16* WG = WSP(bf16, WS_WG); bf16* GBp = WSP(bf16, WS_GB);
    const int tid = F.tid, c16 = F.lane & 15, g16 = F.lane >> 4;
    LAS unsigned char* wl = F.lds;
#pragma unroll
    for (int i = 0; i < 16; ++i) { const int cid = tid + 512 * i, n = cid >> 8, c = cid & 255;
        *(LAS v4u*)(wl + n * 4096 + ((c ^ (n & 15)) << 4)) = *(const GAS v4u*)(WG + (size_t)n * DM + c * 8); }
    __syncthreads();
    const int rt = (int)blockIdx.x + F.G * F.wave;
    if (rt < TA / 16) {
        const bf16* ap = H + (size_t)(rt * 16 + c16) * DM + 8 * g16;
        f32x4 a0 = {0.f, 0.f, 0.f, 0.f}, a1 = a0;
        for (int bt = 0; bt < 4; ++bt) {
            bf16x8 av[16];
#pragma unroll
            for (int q = 0; q < 16; ++q) av[q] = *(const GAS bf16x8*)(ap + 32 * (16 * bt + q));
#pragma unroll
            for (int q = 0; q < 16; ++q) { const int ch = ((4 * (16 * bt + q) + g16) ^ c16) << 4;
                const bf16x8 b0 = *(const LAS bf16x8*)(wl + c16 * 4096 + ch), b1 = *(const LAS bf16x8*)(wl + (16 + c16) * 4096 + ch);
                a0 = __builtin_amdgcn_mfma_f32_16x16x32_bf16(av[q], b0, a0, 0, 0, 0); a1 = __builtin_amdgcn_mfma_f32_16x16x32_bf16(av[q], b1, a1, 0, 0, 0); }
        }
#pragma unroll
        for (int r = 0; r < 4; ++r) { bf16* o = GBp + (size_t)(rt * 16 + 4 * g16 + r) * 32 + c16; o[0] = (bf16)f2bf(a0[r]); o[16] = (bf16)f2bf(a1[r]); }
    }
    __syncthreads();
}
struct EpiProj {
    static constexpr bool PERM = true, AFTER_DRAIN = false;
    bf16* O; const float* rope; float sc;
    __device__ __forceinline__ void operator()(const f32x4 (&acc)[2][2][4][2], const pg8::Unit& u, int wr, int wc, int fr, int fq) const {
        const int row0 = u.pm * 256 + wr * 64 + fr, col0 = u.pn * 256 + wc * 32 + 8 * fq;
        const bool rot = (u.pn < 5) && (u.pm < 64);
        const int fo = (4 * (wc & 1) + fq) * 4;
        f32x4 cs[2][4], sn[2][4];
#pragma unroll
        for (int ai = 0; ai < 2; ++ai)
#pragma unroll
            for (int m = 0; m < 4; ++m) { cs[ai][m] = (f32x4){1.f, 1.f, 1.f, 1.f}; sn[ai][m] = (f32x4){0.f, 0.f, 0.f, 0.f};
                if (rot) { const int s = (row0 + ai * 128 + m * 16) & (SEQ - 1), pos = (wc >> 1) ? (s & 63) : (s >> 6); cs[ai][m] = *(const GAS f32x4*)(rope + pos * 32 + fo); sn[ai][m] = *(const GAS f32x4*)(rope + 2048 + pos * 32 + fo); } }
#pragma unroll
        for (int ai = 0; ai < 2; ++ai)
#pragma unroll
            for (int m = 0; m < 4; ++m) {
                bf16* rowp = O + (size_t)(row0 + ai * 128 + m * 16) * NPRJ + col0;
#pragma unroll
                for (int bj = 0; bj < 2; ++bj) {
                    const f32x4 t1 = acc[ai][bj][m][0] * sc, t2 = acc[ai][bj][m][1] * sc;
                    const f32x4 v0 = t1 * cs[ai][m] - t2 * sn[ai][m], v1 = t2 * cs[ai][m] + t1 * sn[ai][m];
                    v4u w; w.x = pk2(v0[0], v0[1]); w.y = pk2(v0[2], v0[3]); w.z = pk2(v1[0], v1[1]); w.w = pk2(v1[2], v1[3]);
                    *(GAS v4u*)(rowp + bj * 128) = w; }
            }
    }
};

struct EpiCols {
    static constexpr bool PERM = true, AFTER_DRAIN = false;
    bf16* O; int ldc, c0;
    __device__ __forceinline__ void operator()(const f32x4 (&acc)[2][2][4][2], const pg8::Unit& u, int wr, int wc, int fr, int fq) const {
        const int row0 = u.pm * 256 + wr * 64 + fr, col0 = c0 + u.pn * 256 + wc * 32 + 8 * fq;
#pragma unroll
        for (int ai = 0; ai < 2; ++ai)
#pragma unroll
            for (int m = 0; m < 4; ++m) { bf16* rowp = O + (size_t)(row0 + ai * 128 + m * 16) * ldc + col0;
#pragma unroll
                for (int bj = 0; bj < 2; ++bj) { const f32x4 v0 = acc[ai][bj][m][0], v1 = acc[ai][bj][m][1];
                    v4u w; w.x = pk2(v0[0], v0[1]); w.y = pk2(v0[2], v0[3]); w.z = pk2(v1[0], v1[1]); w.w = pk2(v1[2], v1[3]); *(GAS v4u*)(rowp + bj * 128) = w; } }
    }
};
__device__ __forceinline__ v2u tr_rd(unsigned a) { v2u r; asm volatile("ds_read_b64_tr_b16 %0, %1" : "=&v"(r) : "v"(a) : "memory"); return r; }
template <int OFF> __device__ __forceinline__ v2u tr_rdo(unsigned a) { v2u r; asm volatile("ds_read_b64_tr_b16 %0, %1 offset:%2" : "=&v"(r) : "v"(a), "i"(OFF) : "memory"); return r; }
#define TR_ROW4(L, H, base, K) do { L[0] = tr_rdo<(K) * 9216>(base); H[0] = tr_rdo<(K) * 9216 + 4608>(base); L[1] = tr_rdo<(K) * 9216 + 32>(base); H[1] = tr_rdo<(K) * 9216 + 32 + 4608>(base); \
        L[2] = tr_rdo<(K) * 9216 + 64>(base); H[2] = tr_rdo<(K) * 9216 + 64 + 4608>(base); L[3] = tr_rdo<(K) * 9216 + 96>(base); H[3] = tr_rdo<(K) * 9216 + 96 + 4608>(base); } while (0)
#define TR_ROW2(L, H, base, K) do { L[0] = tr_rdo<(K) * 9216>(base); H[0] = tr_rdo<(K) * 9216 + 4608>(base); L[1] = tr_rdo<(K) * 9216 + 32>(base); H[1] = tr_rdo<(K) * 9216 + 32 + 4608>(base); } while (0)
#define LDS_BARRIER() do { asm volatile("s_waitcnt lgkmcnt(0)" ::: "memory"); __builtin_amdgcn_s_barrier(); asm volatile("" ::: "memory"); } while (0)
#define TR_WAIT() do { asm volatile("s_waitcnt lgkmcnt(0)" ::: "memory"); __builtin_amdgcn_sched_barrier(0); } while (0)
__device__ __forceinline__ bf16x8 pk_lohi(v2u lo, v2u hi) { v4u w; w.x = lo.x; w.y = lo.y; w.z = hi.x; w.w = hi.y; return __builtin_bit_cast(bf16x8, w); }
__device__ __forceinline__ bf16x8 pk8(const unsigned (&h)[8]) { v4u w; w.x = h[0] | (h[1] << 16); w.y = h[2] | (h[3] << 16); w.z = h[4] | (h[5] << 16); w.w = h[6] | (h[7] << 16); return __builtin_bit_cast(bf16x8, w); }

constexpr int AT_KB = 17408, AT_VB = 18432, AT_BUF = AT_KB + AT_VB;
__device__ __forceinline__ void attn_unit(Ctx& F, int unit) {
    const int tid = F.tid, lane = F.lane, wave = F.wave, g16 = lane >> 4, c16 = lane & 15;
    const int b = unit >> 7, nblk = (unit >> 2) & 31, hk = (unit >> 1) & 1, gp = unit & 1;
    const int hq = hk * 4 + gp * 2 + (wave >> 2), r0 = (wave & 3) * 32;
    const bf16* PRJ = WSP(bf16, WS_R1); unsigned char* MIX = WSP(unsigned char, WS_MIX);
    const size_t tok0 = (size_t)b * SEQ + (size_t)nblk * 128;
    bf16x8 Qf[2][4];
#pragma unroll
    for (int nq = 0; nq < 2; ++nq)
#pragma unroll
        for (int kk = 0; kk < 4; ++kk) Qf[nq][kk] = *(const GAS bf16x8*)(PRJ + (tok0 + r0 + 16 * nq + c16) * NPRJ + C_QA + hq * 128 + 32 * kk + 8 * g16);
    const unsigned lbase = (unsigned)(uintptr_t)F.lds;
    const unsigned trl = (unsigned)((4 * g16 + (c16 >> 2)) * 288 + (c16 & 3) * 8);
    const int sj = tid >> 3, sd0 = (tid & 7) * 16;
    constexpr float QS = 0.08838834764831845f, QC = QS * 1.4426950408889634f;
    const float sink = F.attn_sink[hq] * (1.f / QS);
    float m_[2] = {sink, sink}, l_[2]; l_[0] = l_[1] = (g16 == 0) ? 1.f : 0.f;
    f32x4 O[8][2];
#pragma unroll
    for (int dt = 0; dt < 8; ++dt) { O[dt][0] = (f32x4){0.f, 0.f, 0.f, 0.f}; O[dt][1] = O[dt][0]; }
    const int n_t = (nblk == 0 || nblk == 31) ? 8 : 10;
    v4u kr[2], vr[2];
#define ATT_TILE(i) ((nblk == 0 && (i) >= 4) ? (i) + 2 : (i))
#define ATT_LOAD(t) do { const int _t = (t); size_t _row; if (_t < 4) _row = (size_t)T + b * CL + _t * 64 + sj; else { const int _bt = _t - 4; _row = (size_t)b * SEQ + (size_t)(nblk - 1 + (_bt >> 1)) * 128 + (_bt & 1) * 64 + sj; } \
        const bf16* _p = PRJ + _row * NPRJ + hk * 128 + sd0; kr[0] = *(const GAS v4u*)(_p + C_KA); kr[1] = *(const GAS v4u*)(_p + C_KA + 8); vr[0] = *(const GAS v4u*)(_p + C_VA); vr[1] = *(const GAS v4u*)(_p + C_VA + 8); } while (0)
#define ATT_WRITE(bufi) do { LAS bf16* _k = (LAS bf16*)(F.lds + (bufi) * AT_BUF); LAS bf16* _v = (LAS bf16*)(F.lds + (bufi) * AT_BUF + AT_KB); \
        *(LAS v4u*)(_k + sj * 136 + sd0) = kr[0]; *(LAS v4u*)(_k + sj * 136 + sd0 + 8) = kr[1]; *(LAS v4u*)(_v + sj * 144 + sd0) = vr[0]; *(LAS v4u*)(_v + sj * 144 + sd0 + 8) = vr[1]; } while (0)
    ATT_LOAD(ATT_TILE(0));
    LDS_BARRIER();
    ATT_WRITE(0);
    if (n_t > 1) ATT_LOAD(ATT_TILE(1));
    for (int i = 0; i < n_t; ++i) {
        const int t = ATT_TILE(i), cur = i & 1;
        LDS_BARRIER();
        if (i + 1 < n_t) ATT_WRITE(cur ^ 1);
        if (i + 2 < n_t) ATT_LOAD(ATT_TILE(i + 2));
        const LAS bf16* KT = (const LAS bf16*)(F.lds + cur * AT_BUF);
        const unsigned vaddr = lbase + cur * AT_BUF + AT_KB + trl;
        const bool band = t >= 4; const int bt = t - 4;
        bool rel = true, msk = false;
        if (band) { const int lo = 64 * bt - 128 - (r0 + 31), hi = 64 * bt + 63 - 128 - r0; rel = (lo <= 128) && (hi >= -128); msk = (lo < -128) || (hi > 128); }
        if (rel) {
            f32x4 S[4][2];
#pragma unroll
            for (int mt = 0; mt < 4; ++mt) { S[mt][0] = (f32x4){0.f, 0.f, 0.f, 0.f}; S[mt][1] = S[mt][0]; }
            __builtin_amdgcn_s_setprio(1);
#pragma unroll
            for (int kk = 0; kk < 4; ++kk)
#pragma unroll
                for (int mt = 0; mt < 4; ++mt) { const bf16x8 Kf = *(const LAS bf16x8*)(KT + (16 * mt + c16) * 136 + 32 * kk + 8 * g16);
                    S[mt][0] = __builtin_amdgcn_mfma_f32_16x16x32_bf16(Kf, Qf[0][kk], S[mt][0], 0, 0, 0); S[mt][1] = __builtin_amdgcn_mfma_f32_16x16x32_bf16(Kf, Qf[1][kk], S[mt][1], 0, 0, 0); }
            __builtin_amdgcn_s_setprio(0);
            if (msk) {
#pragma unroll
                for (int nq = 0; nq < 2; ++nq)
#pragma unroll
                    for (int mt = 0; mt < 4; ++mt)
#pragma unroll
                        for (int r = 0; r < 4; ++r) { const int rl = (64 * bt + 16 * mt + 4 * g16 + r) - 128 - (r0 + 16 * nq + c16); if (rl > 128 || rl < -128) S[mt][nq][r] = -INFINITY; }
            }
#pragma unroll
            for (int nq = 0; nq < 2; ++nq) {
                float tmax = fmaxf(fmaxf(fmaxf(S[0][nq][0], S[0][nq][1]), fmaxf(S[0][nq][2], S[0][nq][3])), fmaxf(fmaxf(S[1][nq][0], S[1][nq][1]), fmaxf(S[1][nq][2], S[1][nq][3])));
                tmax = fmaxf(tmax, fmaxf(fmaxf(fmaxf(S[2][nq][0], S[2][nq][1]), fmaxf(S[2][nq][2], S[2][nq][3])), fmaxf(fmaxf(S[3][nq][0], S[3][nq][1]), fmaxf(S[3][nq][2], S[3][nq][3]))));
                tmax = fmaxf(tmax, __shfl_xor(tmax, 16)); tmax = fmaxf(tmax, __shfl_xor(tmax, 32));
                const float mnew = fmaxf(m_[nq], tmax), alpha = __builtin_amdgcn_exp2f((m_[nq] - mnew) * QC), mc = -mnew * QC; m_[nq] = mnew;
                float ps = 0.f;
#pragma unroll
                for (int mt = 0; mt < 4; ++mt)
#pragma unroll
                    for (int r = 0; r < 4; ++r) { const float p = __builtin_amdgcn_exp2f(__builtin_fmaf(S[mt][nq][r], QC, mc)); S[mt][nq][r] = p; ps += p; }
                l_[nq] = l_[nq] * alpha + ps;
                if (__builtin_amdgcn_ballot_w64(alpha != 1.f) != 0ull) {
#pragma unroll
                    for (int dt = 0; dt < 8; ++dt) O[dt][nq] = O[dt][nq] * alpha; }
            }
#pragma unroll
            for (int kk = 0; kk < 2; ++kk) {
                bf16x8 Pf[2];
#pragma unroll
                for (int nq = 0; nq < 2; ++nq) { v4u w; w.x = pk2(S[2 * kk][nq][0], S[2 * kk][nq][1]); w.y = pk2(S[2 * kk][nq][2], S[2 * kk][nq][3]); w.z = pk2(S[2 * kk + 1][nq][0], S[2 * kk + 1][nq][1]); w.w = pk2(S[2 * kk + 1][nq][2], S[2 * kk + 1][nq][3]);
                    Pf[nq] = __builtin_bit_cast(bf16x8, w); }
                v2u vl[8], vh[8];
                { const unsigned vb = vaddr + kk * 9216;
                    vl[0] = tr_rdo<0>(vb); vh[0] = tr_rdo<4608>(vb); vl[1] = tr_rdo<32>(vb); vh[1] = tr_rdo<32 + 4608>(vb); vl[2] = tr_rdo<64>(vb); vh[2] = tr_rdo<64 + 4608>(vb); vl[3] = tr_rdo<96>(vb); vh[3] = tr_rdo<96 + 4608>(vb);
                    vl[4] = tr_rdo<128>(vb); vh[4] = tr_rdo<128 + 4608>(vb); vl[5] = tr_rdo<160>(vb); vh[5] = tr_rdo<160 + 4608>(vb); vl[6] = tr_rdo<192>(vb); vh[6] = tr_rdo<192 + 4608>(vb); vl[7] = tr_rdo<224>(vb); vh[7] = tr_rdo<224 + 4608>(vb); }
                TR_WAIT();
                __builtin_amdgcn_s_setprio(1);
#pragma unroll
                for (int dt = 0; dt < 8; ++dt) { const bf16x8 Vf = pk_lohi(vl[dt], vh[dt]);
                    O[dt][0] = __builtin_amdgcn_mfma_f32_16x16x32_bf16(Vf, Pf[0], O[dt][0], 0, 0, 0); O[dt][1] = __builtin_amdgcn_mfma_f32_16x16x32_bf16(Vf, Pf[1], O[dt][1], 0, 0, 0); }
                __builtin_amdgcn_s_setprio(0);
            }
        }
    }
#undef ATT_TILE
#undef ATT_LOAD
#undef ATT_WRITE
    LAS unsigned char* stg = F.lds + 73728 + wave * 4608;
#pragma unroll
    for (int nq = 0; nq < 2; ++nq) {
        float l = l_[nq]; l += __shfl_xor(l, 16); l += __shfl_xor(l, 32); const float inv = 1.f / l;
#pragma unroll
        for (int dt = 0; dt < 8; ++dt) { const f32x4 o = O[dt][nq] * inv; *(LAS unsigned*)(stg + (16 * nq + c16) * 144 + 16 * dt + 4 * g16) = pk4_fp8(o[0], o[1], o[2], o[3]); }
    }
    asm volatile("s_waitcnt lgkmcnt(0)" ::: "memory");
#pragma unroll
    for (int it = 0; it < 4; ++it) { const int row = 8 * it + (lane >> 3), pc = lane & 7;
        const v4u w = *(const LAS v4u*)(stg + row * 144 + 16 * pc);
        *(GAS v4u*)(MIX + (tok0 + r0 + row) * DM + hq * 128 + 16 * pc) = w; }
}

constexpr int GW_KD = 0, GW_V = 18432, GW_DEC = 18432 + 34816;
__device__ __forceinline__ void gla_passA_wide(Ctx& F, int unit) {
    const int tid = F.tid, lane = F.lane, wave = F.wave, g16 = lane >> 4, c16 = lane & 15;
    const int uw = unit >> 3, sc8 = unit & 7, b = uw >> 3, h = (uw >> 1) & 3, dir = uw & 1;
    const int p_begin = sc8 == 0 ? 0 : 4 + 8 * (sc8 - 1), nch = sc8 == 0 ? 4 : 8;
    const char* PRJc = (const char*)WSP(bf16, WS_R1); const char* GBc = (const char*)WSP(bf16, WS_GB);
    LAS bf16* KD = (LAS bf16*)(F.lds + GW_KD); LAS bf16* VL = (LAS bf16*)(F.lds + GW_V); LAS float* DEC = (LAS float*)(F.lds + GW_DEC);
    const unsigned lbase = (unsigned)(uintptr_t)F.lds;
    const unsigned trk = (unsigned)((4 * g16 + (c16 >> 2)) * 288 + (c16 & 3) * 8), trv = (unsigned)((4 * g16 + (c16 >> 2)) * 544 + (c16 & 3) * 8);
    bf16x8 Wh;
    { unsigned hi[8];
#pragma unroll
        for (int j = 0; j < 8; ++j) { const float w = g16 < 2 ? F.w_gate_up[(size_t)(dir * 16 + 8 * g16 + j) * 512 + h * 128 + 16 * wave + c16] : 0.f; hi[j] = f2bf(w); }
        Wh = pk8(hi); }
    const float bup = F.b_gate[dir * 512 + h * 128 + 16 * wave + c16];
    bf16x8 U00, U01, UONE;
    { unsigned a0[8], a1[8], one[8];
#pragma unroll
        for (int j = 0; j < 8; ++j) { const int is = 16 * (j >> 2) + 4 * g16 + (j & 3); a0[j] = (is <= c16) ? 0x3F80u : 0u; a1[j] = (is <= 16 + c16) ? 0x3F80u : 0u; one[j] = 0x3F80u; }
        U00 = pk8(a0); U01 = pk8(a1); UONE = pk8(one); }
    const int wr = wave >> 1, wc = wave & 1, sgn = dir ? -1 : 1;
    const int sj = tid >> 3, sd0 = (tid & 7) * 32;
    const int o_gb = sgn * c16 * 64 + (dir * 16 + 8 * (g16 & 1)) * 2;
    const int o_v = sgn * sj * (NPRJ * 2) + (C_VB + h * 256 + sd0) * 2;
    const int o_k = sgn * c16 * (NPRJ * 2) + (C_KB + h * 128 + 16 * wave + 4 * g16) * 2;
    f32x4 Sw[2][8];
#pragma unroll
    for (int mt = 0; mt < 2; ++mt)
#pragma unroll
        for (int nt = 0; nt < 8; ++nt) Sw[mt][nt] = (f32x4){0.f, 0.f, 0.f, 0.f};
    f32x4 logd4 = {0.f, 0.f, 0.f, 0.f};
    v4u gq[4], vr[4]; v2u k4[4];
#define GW_RBASE(pp) ((pp) < 4 ? (T + b * CL + (dir ? (CL - 1 - 64 * (pp)) : 64 * (pp))) : (b * SEQ + (dir ? (SEQ - 1 - 64 * ((pp) - 4)) : 64 * ((pp) - 4))))
#define GW_LOAD(pp) do { const int _rb = GW_RBASE(pp); const char* _gp = GBc + (size_t)_rb * 64; const char* _pp = PRJc + (size_t)_rb * (NPRJ * 2); \
        _Pragma("unroll") for (int mi = 0; mi < 4; ++mi) gq[mi] = *(const GAS v4u*)(_gp + (o_gb + sgn * mi * 1024)); \
        _Pragma("unroll") for (int q = 0; q < 4; ++q) vr[q] = *(const GAS v4u*)(_pp + (o_v + 16 * q)); \
        _Pragma("unroll") for (int ni = 0; ni < 4; ++ni) k4[ni] = *(const GAS v2u*)(_pp + (o_k + sgn * ni * (16 * NPRJ * 2))); } while (0)
    GW_LOAD(p_begin);
    for (int ch = 0; ch < nch; ++ch) {
        const int p = p_begin + ch;
        f32x4 la[4];
#pragma unroll
        for (int mi = 0; mi < 4; ++mi) { const f32x4 zero = {0.f, 0.f, 0.f, 0.f};
            const f32x4 z = __builtin_amdgcn_mfma_f32_16x16x32_bf16(__builtin_bit_cast(bf16x8, gq[mi]), Wh, zero, 0, 0, 0);
#pragma unroll
            for (int r = 0; r < 4; ++r) { const float zz = fmaxf(z[r] + bup, -80.f); la[mi][r] = __builtin_amdgcn_logf(1.f + __builtin_amdgcn_exp2f(zz * -1.4426950408889634f)) * (-1.f / 16.f); } }
        f32x4 bT[4];
        {
            bf16x8 Lh[2];
#pragma unroll
            for (int kk = 0; kk < 2; ++kk) { v4u w; w.x = pk2(la[2 * kk][0], la[2 * kk][1]); w.y = pk2(la[2 * kk][2], la[2 * kk][3]); w.z = pk2(la[2 * kk + 1][0], la[2 * kk + 1][1]); w.w = pk2(la[2 * kk + 1][2], la[2 * kk + 1][3]); Lh[kk] = __builtin_bit_cast(bf16x8, w); }
            const f32x4 zero = {0.f, 0.f, 0.f, 0.f};
            bT[0] = __builtin_amdgcn_mfma_f32_16x16x32_bf16(Lh[0], U00, zero, 0, 0, 0);
            bT[1] = __builtin_amdgcn_mfma_f32_16x16x32_bf16(Lh[0], U01, zero, 0, 0, 0);
            bT[2] = __builtin_amdgcn_mfma_f32_16x16x32_bf16(Lh[0], UONE, zero, 0, 0, 0);
            bT[3] = bT[2];
            bT[2] = __builtin_amdgcn_mfma_f32_16x16x32_bf16(Lh[1], U00, bT[2], 0, 0, 0);
            bT[3] = __builtin_amdgcn_mfma_f32_16x16x32_bf16(Lh[1], U01, bT[3], 0, 0, 0);
        }
        f32x4 blast, dcv;
#pragma unroll
        for (int r = 0; r < 4; ++r) { blast[r] = __shfl(bT[3][r], (lane & 48) | 15); dcv[r] = __builtin_amdgcn_exp2f(blast[r]); }
        logd4 += blast;
        LDS_BARRIER();
#pragma unroll
        for (int q = 0; q < 4; ++q) *(LAS v4u*)(VL + sj * 272 + sd0 + 8 * q) = vr[q];
        if (c16 == 0) *(LAS f32x4*)(DEC + 16 * wave + 4 * g16) = dcv;
#pragma unroll
        for (int ni = 0; ni < 4; ++ni) {
            f32x4 kf, kdv;
            kf[0] = bf2f(k4[ni].x & 0xffffu); kf[1] = bf2f(k4[ni].x >> 16); kf[2] = bf2f(k4[ni].y & 0xffffu); kf[3] = bf2f(k4[ni].y >> 16);
#pragma unroll
            for (int r = 0; r < 4; ++r) kdv[r] = kf[r] * __builtin_amdgcn_exp2f(blast[r] - bT[ni][r]);
            v2u w; w.x = pk2(kdv[0], kdv[1]); w.y = pk2(kdv[2], kdv[3]); *(LAS v2u*)(KD + (16 * ni + c16) * 144 + 16 * wave + 4 * g16) = w;
        }
        LDS_BARRIER();
        if (ch + 1 < nch) GW_LOAD(p + 1);
        {
            const unsigned ka = lbase + GW_KD + trk + 64 * wr, va = lbase + GW_V + trv + 256 * wc;
            v2u al[2][2], ah[2][2];
            al[0][0] = tr_rdo<0>(ka); ah[0][0] = tr_rdo<4608>(ka); al[0][1] = tr_rdo<32>(ka); ah[0][1] = tr_rdo<32 + 4608>(ka);
            al[1][0] = tr_rdo<9216>(ka); ah[1][0] = tr_rdo<9216 + 4608>(ka); al[1][1] = tr_rdo<9216 + 32>(ka); ah[1][1] = tr_rdo<9216 + 32 + 4608>(ka);
            f32x4 dc[2];
#pragma unroll
            for (int mt = 0; mt < 2; ++mt) dc[mt] = *(const LAS f32x4*)(DEC + 32 * wr + 16 * mt + 4 * g16);
            TR_WAIT();
#pragma unroll
            for (int mt = 0; mt < 2; ++mt)
#pragma unroll
                for (int nt = 0; nt < 8; ++nt) Sw[mt][nt] = Sw[mt][nt] * dc[mt];
#define GW_VPAIR(NT, K) pk_lohi(tr_rdo<(K) * 17408 + (NT) * 32>(va), tr_rdo<(K) * 17408 + (NT) * 32 + 8704>(va))
#define GW_MM(NT, v0, v1) do { \
                Sw[0][NT] = __builtin_amdgcn_mfma_f32_16x16x32_bf16(pk_lohi(al[0][0], ah[0][0]), v0, Sw[0][NT], 0, 0, 0); Sw[1][NT] = __builtin_amdgcn_mfma_f32_16x16x32_bf16(pk_lohi(al[0][1], ah[0][1]), v0, Sw[1][NT], 0, 0, 0); \
                Sw[0][NT] = __builtin_amdgcn_mfma_f32_16x16x32_bf16(pk_lohi(al[1][0], ah[1][0]), v1, Sw[0][NT], 0, 0, 0); Sw[1][NT] = __builtin_amdgcn_mfma_f32_16x16x32_bf16(pk_lohi(al[1][1], ah[1][1]), v1, Sw[1][NT], 0, 0, 0); } while (0)
            { const bf16x8 a0 = GW_VPAIR(0, 0), a1 = GW_VPAIR(0, 1), b0 = GW_VPAIR(1, 0), b1 = GW_VPAIR(1, 1), c0 = GW_VPAIR(2, 0), c1 = GW_VPAIR(2, 1), d0 = GW_VPAIR(3, 0), d1 = GW_VPAIR(3, 1); TR_WAIT();
              GW_MM(0, a0, a1); GW_MM(1, b0, b1); GW_MM(2, c0, c1); GW_MM(3, d0, d1); }
            { const bf16x8 a0 = GW_VPAIR(4, 0), a1 = GW_VPAIR(4, 1), b0 = GW_VPAIR(5, 0), b1 = GW_VPAIR(5, 1), c0 = GW_VPAIR(6, 0), c1 = GW_VPAIR(6, 1), d0 = GW_VPAIR(7, 0), d1 = GW_VPAIR(7, 1); TR_WAIT();
              GW_MM(4, a0, a1); GW_MM(5, b0, b1); GW_MM(6, c0, c1); GW_MM(7, d0, d1); }
#undef GW_MM
#define GW_STEP(x)
#undef GW_STEP
#undef GW_VPAIR
        }
    }
#undef GW_LOAD
#undef GW_RBASE
    LDS_BARRIER();
    v2u* L = WSP(v2u, WS_GL) + ((size_t)(unit * 8 + wave) * 16) * 64 + lane;
#pragma unroll
    for (int mt = 0; mt < 2; ++mt)
#pragma unroll
        for (int nt = 0; nt < 8; ++nt) { v2u w; w.x = pk2(Sw[mt][nt][0], Sw[mt][nt][1]); w.y = pk2(Sw[mt][nt][2], Sw[mt][nt][3]); *(GAS v2u*)(L + (mt * 8 + nt) * 64) = w; }
    if (c16 == 0) *(GAS f32x4*)(WSP(float, WS_GLD) + unit * 128 + 16 * wave + 4 * g16) = logd4;
}
constexpr int GC_QM = 0, GC_KM = 17408, GC_QD = 34816, GC_KD = 52224, GC_V = 70656, GC_AT = 105472, GC_DEC = 114688;
__device__ __forceinline__ void gla_passC_wide(Ctx& F, int unit) {
    const int tid = F.tid, lane = F.lane, wave = F.wave, g16 = lane >> 4, c16 = lane & 15;
    const int uw = unit >> 3, sc8c = unit & 7, b = uw >> 3, h = (uw >> 1) & 3, dir = uw & 1;
    const char* PRJc = (const char*)WSP(bf16, WS_R1); const char* GBc = (const char*)WSP(bf16, WS_GB);
    char* OFBc = (char*)(WSP(bf16, WS_R2) + (size_t)dir * T * 1024);
    LAS bf16* QM = (LAS bf16*)(F.lds + GC_QM); LAS bf16* KM = (LAS bf16*)(F.lds + GC_KM); LAS bf16* QD = (LAS bf16*)(F.lds + GC_QD);
    LAS bf16* KD = (LAS bf16*)(F.lds + GC_KD); LAS bf16* VL = (LAS bf16*)(F.lds + GC_V); LAS bf16* AT = (LAS bf16*)(F.lds + GC_AT); LAS float* DEC = (LAS float*)(F.lds + GC_DEC);
    const unsigned lbase = (unsigned)(uintptr_t)F.lds;
    const unsigned trk = (unsigned)((4 * g16 + (c16 >> 2)) * 288 + (c16 & 3) * 8), trv = (unsigned)((4 * g16 + (c16 >> 2)) * 544 + (c16 & 3) * 8);
    bf16x8 Wh;
    { unsigned hi[8];
#pragma unroll
        for (int j = 0; j < 8; ++j) { const float w = g16 < 2 ? F.w_gate_up[(size_t)(dir * 16 + 8 * g16 + j) * 512 + h * 128 + 16 * wave + c16] : 0.f; hi[j] = f2bf(w); }
        Wh = pk8(hi); }
    const float bup = F.b_gate[dir * 512 + h * 128 + 16 * wave + c16];
    bf16x8 U00, U01, UONE;
    { unsigned a0[8], a1[8], one[8];
#pragma unroll
        for (int j = 0; j < 8; ++j) { const int is = 16 * (j >> 2) + 4 * g16 + (j & 3); a0[j] = (is <= c16) ? 0x3F80u : 0u; a1[j] = (is <= 16 + c16) ? 0x3F80u : 0u; one[j] = 0x3F80u; }
        U00 = pk8(a0); U01 = pk8(a1); UONE = pk8(one); }
    const int sgn = dir ? -1 : 1;
    const int sj = tid >> 3, sd0 = (tid & 7) * 32;
    const int o_gb = sgn * c16 * 64 + (dir * 16 + 8 * (g16 & 1)) * 2;
    const int o_v = sgn * sj * (NPRJ * 2) + (C_VB + h * 256 + sd0) * 2;
    const int o_qk = sgn * c16 * (NPRJ * 2) + (h * 128 + 16 * wave + 4 * g16) * 2;
    const int o_out = sgn * c16 * 2048 + (h * 256 + 32 * wave + 4 * g16) * 2;
    f32x4 Sc[8][2];
#ifdef PROBE_FOLD
    for (int rep_ = 0; rep_ < PROBE_FOLD; ++rep_)
#endif
    {
#ifdef PROBE_FOLD
        size_t zo_ = 0; asm volatile("" : "+s"(zo_));
        const v2u* Lb = WSP(v2u, WS_GL) + zo_ + (size_t)(uw * 8) * 8 * 16 * 64 + lane;
#else
        const v2u* Lb = WSP(v2u, WS_GL) + (size_t)(uw * 8) * 8 * 16 * 64 + lane;
#endif
        const float* LD = WSP(float, WS_GLD) + (size_t)uw * 8 * 128;
#define GC_LST(w_) ((f32x4){bf2f((w_).x & 0xffffu), __builtin_bit_cast(float, (w_).x & 0xffff0000u), bf2f((w_).y & 0xffffu), __builtin_bit_cast(float, (w_).y & 0xffff0000u)})
#pragma unroll
        for (int mt = 0; mt < 8; ++mt)
#pragma unroll
            for (int nt = 0; nt < 2; ++nt) { const int dvt = 2 * wave + nt; const v2u w = *(const GAS v2u*)(Lb + ((size_t)(2 * (mt >> 1) + (dvt >> 3)) * 16 + ((mt & 1) * 8 + (dvt & 7))) * 64); Sc[mt][nt] = GC_LST(w); }
        for (int s = 1; s <= sc8c; ++s) {
#pragma unroll
            for (int mt = 0; mt < 8; ++mt) { const f32x4 ld = *(const GAS f32x4*)(LD + s * 128 + 16 * mt + 4 * g16);
                const f32x4 dc = {__builtin_amdgcn_exp2f(ld.x), __builtin_amdgcn_exp2f(ld.y), __builtin_amdgcn_exp2f(ld.z), __builtin_amdgcn_exp2f(ld.w)};
#pragma unroll
                for (int nt = 0; nt < 2; ++nt) { const int dvt = 2 * wave + nt; const v2u w = *(const GAS v2u*)(Lb + ((size_t)s * 8 * 16 + (size_t)(2 * (mt >> 1) + (dvt >> 3)) * 16 + ((mt & 1) * 8 + (dvt & 7))) * 64); Sc[mt][nt] = Sc[mt][nt] * dc + GC_LST(w); } }
        }
#undef GC_LST
    }
    for (int i = tid; i < 64 * 72 / 2; i += 512) ((LAS unsigned*)AT)[i] = 0u;
    const int p_begin = 4 + 8 * sc8c;
    v4u gq[4], vr[4]; v2u k4[4], q4[4];
#define GC_RBASE(pp) (b * SEQ + (dir ? (SEQ - 1 - 64 * ((pp) - 4)) : 64 * ((pp) - 4)))
#define GC_LOAD(pp) do { const int _rb = GC_RBASE(pp); const char* _gp = GBc + (size_t)_rb * 64; const char* _pp = PRJc + (size_t)_rb * (NPRJ * 2); \
        _Pragma("unroll") for (int mi = 0; mi < 4; ++mi) gq[mi] = *(const GAS v4u*)(_gp + (o_gb + sgn * mi * 1024)); \
        _Pragma("unroll") for (int q = 0; q < 4; ++q) vr[q] = *(const GAS v4u*)(_pp + (o_v + 16 * q)); \
        _Pragma("unroll") for (int ni = 0; ni < 4; ++ni) { k4[ni] = *(const GAS v2u*)(_pp + (o_qk + sgn * ni * (16 * NPRJ * 2) + C_KB * 2)); q4[ni] = *(const GAS v2u*)(_pp + (o_qk + sgn * ni * (16 * NPRJ * 2) + C_QB * 2)); } } while (0)
    GC_LOAD(p_begin);
    { char* op = OFBc + (size_t)GC_RBASE(p_begin) * 2048 + o_out;
#pragma unroll
        for (int tq = 0; tq < 4; ++tq)
#pragma unroll
            for (int nt = 0; nt < 2; ++nt) { v2u w; w.x = 0u; w.y = 0u; *(GAS v2u*)(op + sgn * tq * (16 * 2048) + 32 * nt) = w; } }
    for (int ch = 0; ch < 8; ++ch) {
        const int p = p_begin + ch;
        const int rbase = GC_RBASE(p);
        f32x4 la[4];
#pragma unroll
        for (int mi = 0; mi < 4; ++mi) { const f32x4 zero = {0.f, 0.f, 0.f, 0.f};
            const f32x4 z = __builtin_amdgcn_mfma_f32_16x16x32_bf16(__builtin_bit_cast(bf16x8, gq[mi]), Wh, zero, 0, 0, 0);
#pragma unroll
            for (int r = 0; r < 4; ++r) { const float zz = fmaxf(z[r] + bup, -80.f); la[mi][r] = __builtin_amdgcn_logf(1.f + __builtin_amdgcn_exp2f(zz * -1.4426950408889634f)) * (-1.f / 16.f); } }
        f32x4 bT[4];
        {
            bf16x8 Lh[2];
#pragma unroll
            for (int kk = 0; kk < 2; ++kk) { v4u w; w.x = pk2(la[2 * kk][0], la[2 * kk][1]); w.y = pk2(la[2 * kk][2], la[2 * kk][3]); w.z = pk2(la[2 * kk + 1][0], la[2 * kk + 1][1]); w.w = pk2(la[2 * kk + 1][2], la[2 * kk + 1][3]); Lh[kk] = __builtin_bit_cast(bf16x8, w); }
            const f32x4 zero = {0.f, 0.f, 0.f, 0.f};
            bT[0] = __builtin_amdgcn_mfma_f32_16x16x32_bf16(Lh[0], U00, zero, 0, 0, 0);
            bT[1] = __builtin_amdgcn_mfma_f32_16x16x32_bf16(Lh[0], U01, zero, 0, 0, 0);
            bT[2] = __builtin_amdgcn_mfma_f32_16x16x32_bf16(Lh[0], UONE, zero, 0, 0, 0);
            bT[3] = bT[2];
            bT[2] = __builtin_amdgcn_mfma_f32_16x16x32_bf16(Lh[1], U00, bT[2], 0, 0, 0);
            bT[3] = __builtin_amdgcn_mfma_f32_16x16x32_bf16(Lh[1], U01, bT[3], 0, 0, 0);
        }
        f32x4 bmid, blast;
#pragma unroll
        for (int r = 0; r < 4; ++r) { bmid[r] = __shfl(bT[1][r], (lane & 48) | 15); blast[r] = __shfl(bT[3][r], (lane & 48) | 15); }
        f32x4 c1, c2, c3, dcv;
#pragma unroll
        for (int r = 0; r < 4; ++r) { c1[r] = __builtin_amdgcn_exp2f(-bmid[r]) * 0.08838834764831845f; c2[r] = __builtin_amdgcn_exp2f(bmid[r]); c3[r] = __builtin_amdgcn_exp2f(blast[r] - bmid[r]); dcv[r] = __builtin_amdgcn_exp2f(blast[r]); }
        LDS_BARRIER();
#pragma unroll
        for (int q = 0; q < 4; ++q) *(LAS v4u*)(VL + sj * 272 + sd0 + 8 * q) = vr[q];
        if (c16 == 0) *(LAS f32x4*)(DEC + 16 * wave + 4 * g16) = dcv;
#pragma unroll
        for (int ni = 0; ni < 4; ++ni) {
            const int i = 16 * ni + c16, dcol = 16 * wave + 4 * g16;
            f32x4 kf, qf, E, R;
            kf[0] = bf2f(k4[ni].x & 0xffffu); kf[1] = bf2f(k4[ni].x >> 16); kf[2] = bf2f(k4[ni].y & 0xffffu); kf[3] = bf2f(k4[ni].y >> 16);
            qf[0] = bf2f(q4[ni].x & 0xffffu); qf[1] = bf2f(q4[ni].x >> 16); qf[2] = bf2f(q4[ni].y & 0xffffu); qf[3] = bf2f(q4[ni].y >> 16);
#pragma unroll
            for (int r = 0; r < 4; ++r) { E[r] = __builtin_amdgcn_exp2f(bT[ni][r]); R[r] = __builtin_amdgcn_rcpf(E[r]); }
            const f32x4 kmv = kf * c2 * R, kdv = kmv * c3, qmv = qf * c1 * E, qdv = qf * 0.08838834764831845f * E;
            v2u w; w.x = pk2(kdv[0], kdv[1]); w.y = pk2(kdv[2], kdv[3]); *(LAS v2u*)(KD + i * 144 + dcol) = w;
            w.x = pk2(qmv[0], qmv[1]); w.y = pk2(qmv[2], qmv[3]); *(LAS v2u*)(QM + i * 136 + dcol) = w;
            w.x = pk2(kmv[0], kmv[1]); w.y = pk2(kmv[2], kmv[3]); *(LAS v2u*)(KM + i * 136 + dcol) = w;
            w.x = pk2(qdv[0], qdv[1]); w.y = pk2(qdv[2], qdv[3]); *(LAS v2u*)(QD + i * 136 + dcol) = w;
        }
        LDS_BARRIER();
        if (ch + 1 < 8) GC_LOAD(p + 1);
        for (int tl = wave; tl < 10; tl += 8) {
            const int tq = tl >= 6 ? 3 : tl >= 3 ? 2 : tl >= 1 ? 1 : 0, mt = tl - (tq * (tq + 1)) / 2;
            f32x4 a = {0.f, 0.f, 0.f, 0.f};
#pragma unroll
            for (int kk = 0; kk < 4; ++kk) { const bf16x8 Qf = *(const LAS bf16x8*)(QM + (16 * tq + c16) * 136 + 32 * kk + 8 * g16), Kf = *(const LAS bf16x8*)(KM + (16 * mt + c16) * 136 + 32 * kk + 8 * g16);
                a = __builtin_amdgcn_mfma_f32_16x16x32_bf16(Kf, Qf, a, 0, 0, 0); }
            if (mt == tq) {
#pragma unroll
                for (int r = 0; r < 4; ++r) if (4 * g16 + r > c16) a[r] = 0.f; }
            v2u w; w.x = pk2(a[0], a[1]); w.y = pk2(a[2], a[3]); *(LAS v2u*)(AT + (16 * tq + c16) * 72 + 16 * mt + 4 * g16) = w;
        }
        LDS_BARRIER();
        const unsigned va = lbase + GC_V + trv + 64 * wave;
        bf16x8 Vf[2][2];
        Vf[0][0] = pk_lohi(tr_rdo<0>(va), tr_rdo<8704>(va)); Vf[0][1] = pk_lohi(tr_rdo<17408>(va), tr_rdo<17408 + 8704>(va));
        Vf[1][0] = pk_lohi(tr_rdo<32>(va), tr_rdo<32 + 8704>(va)); Vf[1][1] = pk_lohi(tr_rdo<17408 + 32>(va), tr_rdo<17408 + 32 + 8704>(va));
        TR_WAIT();
        f32x4 OT[2][4];
#pragma unroll
        for (int nt = 0; nt < 2; ++nt)
#pragma unroll
            for (int tq = 0; tq < 4; ++tq) OT[nt][tq] = (f32x4){0.f, 0.f, 0.f, 0.f};
#pragma unroll
        for (int tq = 0; tq < 4; ++tq)
#pragma unroll
            for (int kk = 0; kk < 2; ++kk) if (kk == 0 || tq >= 2) {
                const LAS bf16* ap = AT + (16 * tq + c16) * 72 + 32 * kk + 4 * g16;
                const bf16x8 Af = pk_lohi(*(const LAS v2u*)ap, *(const LAS v2u*)(ap + 16));
                OT[0][tq] = __builtin_amdgcn_mfma_f32_16x16x32_bf16(Vf[0][kk], Af, OT[0][tq], 0, 0, 0); OT[1][tq] = __builtin_amdgcn_mfma_f32_16x16x32_bf16(Vf[1][kk], Af, OT[1][tq], 0, 0, 0); }
#pragma unroll
        for (int kq = 0; kq < 4; ++kq) {
            bf16x8 Sf[2];
#pragma unroll
            for (int nt = 0; nt < 2; ++nt) { v4u w; w.x = pk2(Sc[2 * kq][nt][0], Sc[2 * kq][nt][1]); w.y = pk2(Sc[2 * kq][nt][2], Sc[2 * kq][nt][3]); w.z = pk2(Sc[2 * kq + 1][nt][0], Sc[2 * kq + 1][nt][1]); w.w = pk2(Sc[2 * kq + 1][nt][2], Sc[2 * kq + 1][nt][3]); Sf[nt] = __builtin_bit_cast(bf16x8, w); }
#pragma unroll
            for (int tq = 0; tq < 4; ++tq) { const LAS bf16* qp = QD + (16 * tq + c16) * 136 + 32 * kq + 4 * g16;
                const bf16x8 Qf = pk_lohi(*(const LAS v2u*)qp, *(const LAS v2u*)(qp + 16));
                OT[0][tq] = __builtin_amdgcn_mfma_f32_16x16x32_bf16(Sf[0], Qf, OT[0][tq], 0, 0, 0); OT[1][tq] = __builtin_amdgcn_mfma_f32_16x16x32_bf16(Sf[1], Qf, OT[1][tq], 0, 0, 0); }
        }
        { char* op = OFBc + (size_t)rbase * 2048 + o_out;
#pragma unroll
            for (int tq = 0; tq < 4; ++tq)
#pragma unroll
                for (int nt = 0; nt < 2; ++nt) { v2u w; w.x = pk2(OT[nt][tq][0], OT[nt][tq][1]); w.y = pk2(OT[nt][tq][2], OT[nt][tq][3]); *(GAS v2u*)(op + sgn * tq * (16 * 2048) + 32 * nt) = w; } }
        {
            const unsigned ka = lbase + GC_KD + trk;
#define GC_KPAIR(MT, K) pk_lohi(tr_rdo<(K) * 9216 + (MT) * 32>(ka), tr_rdo<(K) * 9216 + (MT) * 32 + 4608>(ka))
#define GC_MM(MT, k0, k1) do { const f32x4 dc = *(const LAS f32x4*)(DEC + 16 * (MT) + 4 * g16); Sc[MT][0] = Sc[MT][0] * dc; Sc[MT][1] = Sc[MT][1] * dc; \
                Sc[MT][0] = __builtin_amdgcn_mfma_f32_16x16x32_bf16(k0, Vf[0][0], Sc[MT][0], 0, 0, 0); Sc[MT][1] = __builtin_amdgcn_mfma_f32_16x16x32_bf16(k0, Vf[1][0], Sc[MT][1], 0, 0, 0); \
                Sc[MT][0] = __builtin_amdgcn_mfma_f32_16x16x32_bf16(k1, Vf[0][1], Sc[MT][0], 0, 0, 0); Sc[MT][1] = __builtin_amdgcn_mfma_f32_16x16x32_bf16(k1, Vf[1][1], Sc[MT][1], 0, 0, 0); } while (0)
#define GC_ROW2(M0) do { const bf16x8 a0 = GC_KPAIR(M0, 0), a1 = GC_KPAIR(M0, 1), b0 = GC_KPAIR((M0) + 1, 0), b1 = GC_KPAIR((M0) + 1, 1); TR_WAIT(); GC_MM(M0, a0, a1); GC_MM((M0) + 1, b0, b1); } while (0)
            GC_ROW2(0); GC_ROW2(2); GC_ROW2(4); GC_ROW2(6);
#undef GC_ROW2
#undef GC_MM
#define GC_ROW(x)
#undef GC_ROW
#undef GC_KPAIR
        }
    }
#undef GC_LOAD
#undef GC_RBASE
    LDS_BARRIER();
}
__device__ __forceinline__ void p6_gla_out(Ctx& F) {
    const bf16* OF = WSP(bf16, WS_R2); const bf16* OB = OF + (size_t)T * 1024; const bf16* PRJ = WSP(bf16, WS_R1); unsigned char* MIX = WSP(unsigned char, WS_MIX);
    const int gw = blockIdx.x * 8 + F.wave, NGW = F.G * 8, lane = F.lane;
    f32x4 nw[4];
#pragma unroll
    for (int j = 0; j < 4; ++j) nw[j] = *(const GAS f32x4*)(F.gla_norm_w + 16 * lane + 4 * j);
    v4u a0, a1, b0, b1, r0, r1;
#define P6_LOAD(t_) do { a0 = *(const GAS v4u*)(OF + (size_t)(t_) * 1024 + 16 * lane); a1 = *(const GAS v4u*)(OF + (size_t)(t_) * 1024 + 16 * lane + 8); \
        b0 = *(const GAS v4u*)(OB + (size_t)(t_) * 1024 + 16 * lane); b1 = *(const GAS v4u*)(OB + (size_t)(t_) * 1024 + 16 * lane + 8); \
        r0 = *(const GAS v4u*)(PRJ + (size_t)(t_) * NPRJ + C_RB + 16 * lane); r1 = *(const GAS v4u*)(PRJ + (size_t)(t_) * NPRJ + C_RB + 16 * lane + 8); } while (0)
    if (gw < T) P6_LOAD(gw);
    for (int t = gw; t < T; t += NGW) {
        float o[16], rv[16]; float ss = 0.f;
#pragma unroll
        for (int j = 0; j < 4; ++j) { o[2 * j] = bf2f(a0[j] & 0xffffu) + bf2f(b0[j] & 0xffffu); o[2 * j + 1] = bf2f(a0[j] >> 16) + bf2f(b0[j] >> 16); o[8 + 2 * j] = bf2f(a1[j] & 0xffffu) + bf2f(b1[j] & 0xffffu); o[8 + 2 * j + 1] = bf2f(a1[j] >> 16) + bf2f(b1[j] >> 16);
            rv[2 * j] = bf2f(r0[j] & 0xffffu); rv[2 * j + 1] = bf2f(r0[j] >> 16); rv[8 + 2 * j] = bf2f(r1[j] & 0xffffu); rv[8 + 2 * j + 1] = bf2f(r1[j] >> 16); }
        if (t + NGW < T) P6_LOAD(t + NGW);
#pragma unroll
        for (int j = 0; j < 16; ++j) ss += o[j] * o[j];
        ss += __shfl_xor(ss, 1); ss += __shfl_xor(ss, 2); ss += __shfl_xor(ss, 4); ss += __shfl_xor(ss, 8);
        const float rs = 1.f / sqrtf(ss * (1.f / 256.f) + LN_EPS);
        float y[16];
#pragma unroll
        for (int j = 0; j < 4; ++j)
#pragma unroll
            for (int e = 0; e < 4; ++e) y[4 * j + e] = o[4 * j + e] * rs * nw[j][e] * silu_f(rv[4 * j + e]);
        v4u w; w.x = pk4_fp8(y[0], y[1], y[2], y[3]); w.y = pk4_fp8(y[4], y[5], y[6], y[7]); w.z = pk4_fp8(y[8], y[9], y[10], y[11]); w.w = pk4_fp8(y[12], y[13], y[14], y[15]);
        *(GAS v4u*)(MIX + (size_t)t * DM + 1024 + 16 * lane) = w;
    }
#undef P6_LOAD
}


__device__ __forceinline__ f32x4 ld_bf4(const bf16* p) { const v2u w = *(const GAS v2u*)p; f32x4 r; r.x = bf2f(w.x & 0xffffu); r.y = bf2f(w.x >> 16); r.z = bf2f(w.y & 0xffffu); r.w = bf2f(w.y >> 16); return r; }
__device__ __forceinline__ void st_bf4(bf16* p, f32x4 v) { v2u w; w.x = pk2(v.x, v.y); w.y = pk2(v.z, v.w); *(GAS v2u*)p = w; }
struct EpiX1 {
    static constexpr bool PERM = true, AFTER_DRAIN = false;
    const float* x; const float* mod; bf16* X1; float sc;
    __device__ __forceinline__ void operator()(const f32x4 (&acc)[2][2][4][2], const pg8::Unit& u, int wr, int wc, int fr, int fq) const {
        const int row0 = u.pm * 256 + wr * 64 + fr, col0 = u.pn * 256 + wc * 32 + 8 * fq;
        const float* g1 = mod + (size_t)(u.pm >> 4) * NMOD + 2 * DM + col0;
        f32x4 gv[2][2];
#pragma unroll
        for (int bj = 0; bj < 2; ++bj)
#pragma unroll
            for (int n = 0; n < 2; ++n) gv[bj][n] = *(const GAS f32x4*)(g1 + bj * 128 + n * 4) * sc;
        f32x4 xa[2][2][2], xb[2][2][2];
#define X1_LOAD(dst, g) do { _Pragma("unroll") for (int mm = 0; mm < 2; ++mm) _Pragma("unroll") for (int bj = 0; bj < 2; ++bj) { const size_t off = (size_t)(row0 + ((g) >> 1) * 128 + (2 * ((g) & 1) + mm) * 16) * DM + col0 + bj * 128; \
            dst[mm][bj][0] = *(const GAS f32x4*)(x + off); dst[mm][bj][1] = *(const GAS f32x4*)(x + off + 4); } } while (0)
#define X1_STORE(src, g) do { _Pragma("unroll") for (int mm = 0; mm < 2; ++mm) _Pragma("unroll") for (int bj = 0; bj < 2; ++bj) { const int ai = (g) >> 1, m = 2 * ((g) & 1) + mm; const size_t off = (size_t)(row0 + ai * 128 + m * 16) * DM + col0 + bj * 128; \
            const f32x4 v0 = src[mm][bj][0] * ALPHA + gv[bj][0] * acc[ai][bj][m][0], v1 = src[mm][bj][1] * ALPHA + gv[bj][1] * acc[ai][bj][m][1]; \
            v4u w; w.x = pk2(v0[0], v0[1]); w.y = pk2(v0[2], v0[3]); w.z = pk2(v1[0], v1[1]); w.w = pk2(v1[2], v1[3]); *(GAS v4u*)(X1 + off) = w; } } while (0)
        X1_LOAD(xa, 0); X1_LOAD(xb, 1); X1_STORE(xa, 0); X1_LOAD(xa, 2); X1_STORE(xb, 1); X1_LOAD(xb, 3); X1_STORE(xa, 2); X1_STORE(xb, 3);
#undef X1_LOAD
#undef X1_STORE
    }
};
struct EpiSwiGLU {
    static constexpr bool PERM = true, AFTER_DRAIN = false;
    unsigned char* HID;
    __device__ __forceinline__ void operator()(const f32x4 (&acc)[2][2][4][2], const pg8::Unit& u, int wr, int wc, int fr, int fq) const {
        const int row0 = u.pm * 256 + wr * 64 + fr, col0 = u.pn * 128 + wc * 32 + 8 * fq;
#pragma unroll
        for (int ai = 0; ai < 2; ++ai)
#pragma unroll
            for (int m = 0; m < 4; ++m) { f32x4 h0, h1;
#pragma unroll
                for (int j = 0; j < 4; ++j) { h0[j] = silu_f(acc[ai][0][m][0][j] * W8_INV) * (acc[ai][1][m][0][j] * W8_INV); h1[j] = silu_f(acc[ai][0][m][1][j] * W8_INV) * (acc[ai][1][m][1][j] * W8_INV); }
                v2u w; w.x = pk4_fp8(h0[0], h0[1], h0[2], h0[3]); w.y = pk4_fp8(h1[0], h1[1], h1[2], h1[3]);
                *(GAS v2u*)(HID + (size_t)(row0 + ai * 128 + m * 16) * EH + col0) = w; }
    }
};
struct EpiPlain {
    static constexpr bool PERM = true, AFTER_DRAIN = false;
    unsigned char* O; int ldc; float sc;
    __device__ __forceinline__ void operator()(const f32x4 (&acc)[2][2][4][2], const pg8::Unit& u, int wr, int wc, int fr, int fq) const {
        const int row0 = u.pm * 256 + wr * 64 + fr, col0 = u.pn * 256 + wc * 32 + 8 * fq;
#pragma unroll
        for (int ai = 0; ai < 2; ++ai)
#pragma unroll
            for (int m = 0; m < 4; ++m) { unsigned char* rowp = O + (size_t)(row0 + ai * 128 + m * 16) * ldc + col0;
#pragma unroll
                for (int bj = 0; bj < 2; ++bj) { const f32x4 v0 = acc[ai][bj][m][0] * sc, v1 = acc[ai][bj][m][1] * sc;
                    v2u w; w.x = pk4_fp8(v0[0], v0[1], v0[2], v0[3]); w.y = pk4_fp8(v1[0], v1[1], v1[2], v1[3]); *(GAS v2u*)(rowp + bj * 128) = w; } }
    }
};
#ifndef WGM_P3A
#define WGM_P3A 2
#endif
#ifndef WGM_P3B
#define WGM_P3B 2
#endif
#ifndef WGM_P7
#define WGM_P7 2
#endif
#ifndef MOE_WGM
#define MOE_WGM 8
#endif
template <bool GATHER_>
struct MoeOrderT {
    static constexpr bool GATHER = GATHER_;
    int nM, nN, nwg, G, c; const LAS int* tile_e; const LAS int* rows;
    __device__ __forceinline__ bool next(int i, pg8::Unit& u) const {
        const int L = i * G + c; if (L >= nwg) return false;
        int wgid = L; { const int q = nwg / 8, r = nwg % 8, xcd = wgid % 8, off = wgid / 8; wgid = (xcd < r ? xcd * (q + 1) : r * (q + 1) + (xcd - r) * q) + off; }
        const int nig = MOE_WGM * nN, gid = wgid / nig, fm = gid * MOE_WGM, gsz = (nM - fm) < MOE_WGM ? (nM - fm) : MOE_WGM;
        u.pm = fm + ((wgid % nig) % gsz); u.pn = (wgid % nig) / gsz; u.e = __builtin_amdgcn_readfirstlane(tile_e[u.pm]); return true;
    }
    __device__ __forceinline__ void a_ready(const pg8::Unit&) const {}
    __device__ __forceinline__ void done(const pg8::Unit&) const {}
};
typedef MoeOrderT<false> MoeOrder; typedef MoeOrderT<true> MoeOrderG;

template <bool DRY = false>
__device__ __forceinline__ void p8_ln_route(Ctx& F) {
    const int wave = F.wave;
    const bf16* X1i = WSP(bf16, WS_X1); f32x2* ROWST = DRY ? WSP(f32x2, WS_R1) : WSP(f32x2, TOK_ROWST); unsigned char* H2 = DRY ? WSP(unsigned char, WS_R1 + 70 * MiB) : WSP(unsigned char, WS_R2); const float* MOD = WSP(float, WS_MOD);
    const bf16* WQH = WSP(bf16, WS_WQH); const bf16* WQL = WSP(bf16, WS_WQL); const float* UV = WSP(float, WS_UV);
    constexpr size_t DO = DRY ? (WS_R1 + 110 * MiB - WS_TOK) : 0;
    int* tok_e = WSP(int, TOK_E + DO); int* tok_rank = WSP(int, TOK_RANK + DO); float* tok_w = WSP(float, TOK_W + DO); int* cntblk = WSP(int, TOK_CNT + DO);
    LAS f32x4* STAT = (LAS f32x4*)(F.lds);
    LAS f32x4* CST = (LAS f32x4*)(F.lds + 32768);
    LAS float* LGP = (LAS float*)(F.lds + 65536);
    LAS float* UVL = (LAS float*)(F.lds + 1024);
    for (int vb = blockIdx.x; vb < 256; vb += F.G) {
        const int t0 = vb * 64, bb = t0 >> 12;
        const float* mrow = MOD + (size_t)bb * NMOD;
        int tz0_ = threadIdx.x; asm volatile("" : "+v"(tz0_));
        const int tid = tz0_, lane = tz0_ & 63, g16 = (tz0_ >> 4) & 3, c16 = tz0_ & 15;
        f32x4 a3[4][3];
#pragma unroll
        for (int tile = 0; tile < 4; ++tile)
#pragma unroll
            for (int nt = 0; nt < 3; ++nt) a3[tile][nt] = (f32x4){0.f, 0.f, 0.f, 0.f};
        {
            const f32x4 c0 = *(const GAS f32x4*)(F.ln1_g + 4 * tid), c1 = *(const GAS f32x4*)(F.ln1_b + 4 * tid), c2 = *(const GAS f32x4*)(mrow + 3 * DM + 4 * tid), c3 = *(const GAS f32x4*)(mrow + 4 * DM + 4 * tid);
            const int kw = 256 * wave + 8 * g16;
            const bf16* xr = X1i + (size_t)(t0 + c16) * DM + kw; const bf16* wh = WQH + (size_t)(bb * 48 + c16) * DM + kw; const bf16* wl = WQL + (size_t)(bb * 48 + c16) * DM + kw;
            bf16x8 xa[4], bh[3], bl[3];
#define P8_RLD(kk) do { \
                _Pragma("unroll") for (int nt = 0; nt < 3; ++nt) { bh[nt] = *(const GAS bf16x8*)(wh + (size_t)nt * 16 * DM + 32 * (kk)); bl[nt] = *(const GAS bf16x8*)(wl + (size_t)nt * 16 * DM + 32 * (kk)); } \
                _Pragma("unroll") for (int tile = 0; tile < 4; ++tile) xa[tile] = *(const GAS bf16x8*)(xr + (size_t)tile * 16 * DM + 32 * (kk)); } while (0)
            v2u nx[4][8];
#define P8_XLD(i_) do { _Pragma("unroll") for (int j = 0; j < 8; ++j) nx[(i_) & 3][j] = *(const GAS v2u*)(X1i + (size_t)(t0 + 8 * wave + (i_)) * DM + 4 * lane + 256 * j); } while (0)
            P8_XLD(0); P8_XLD(1); P8_RLD(0); P8_XLD(2); P8_XLD(3);
            CST[tid] = c0; CST[512 + tid] = c1; CST[1024 + tid] = c2; CST[1536 + tid] = c3 + 1.f;
            if (tid < 192) UVL[tid] = UV[bb * 192 + tid];
            __syncthreads();
#pragma unroll
            for (int i = 0; i < 8; ++i) {
                const int t = t0 + 8 * wave + i;
                unsigned co_ = 32768u + 16u * (unsigned)lane; asm volatile("" : "+v"(co_));
                const LAS f32x4* CSTl = (const LAS f32x4*)(F.lds + co_);
                f32x4 v[8]; f32x4 sv = {0.f, 0.f, 0.f, 0.f}, qv = {0.f, 0.f, 0.f, 0.f};
#pragma unroll
                for (int j = 0; j < 8; ++j) { const v2u w = nx[i & 3][j]; v[j].x = bf2f(w.x & 0xffffu); v[j].y = __builtin_bit_cast(float, w.x & 0xffff0000u); v[j].z = bf2f(w.y & 0xffffu); v[j].w = __builtin_bit_cast(float, w.y & 0xffff0000u);
                    sv += v[j]; qv = v[j] * v[j] + qv; }
                const float mean = wave_sum((sv.x + sv.y) + (sv.z + sv.w)) * (1.f / DM), ex2 = wave_sum((qv.x + qv.y) + (qv.z + qv.w)) * (1.f / DM);
                const float rstd = 1.f / sqrtf(fmaxf(ex2 - mean * mean, 0.f) + LN_EPS), nm = -mean * rstd;
                f32x4 sv2 = {0.f, 0.f, 0.f, 0.f}, qv2 = {0.f, 0.f, 0.f, 0.f};
#pragma unroll
                for (int j = 0; j < 8; ++j) { v[j] = (v[j] * rstd + nm) * CSTl[64 * j] + CSTl[512 + 64 * j]; sv2 += v[j]; qv2 = v[j] * v[j] + qv2; }
                const float mean2 = wave_sum((sv2.x + sv2.y) + (sv2.z + sv2.w)) * (1.f / DM), ey2 = wave_sum((qv2.x + qv2.y) + (qv2.z + qv2.w)) * (1.f / DM);
                const float rstd2 = 1.f / sqrtf(fmaxf(ey2 - mean2 * mean2, 0.f) + LN_EPS), nm2 = -mean2 * rstd2;
                unsigned hq[8];
#pragma unroll
                for (int j = 0; j < 8; ++j) { const f32x4 h = (v[j] * rstd2 + nm2) * CSTl[1536 + 64 * j] + CSTl[1024 + 64 * j]; hq[j] = pk4_fp8(h.x, h.y, h.z, h.w); }
#pragma unroll
                for (int tile = 0; tile < 4; ++tile)
#pragma unroll
                    for (int nt = 0; nt < 3; ++nt) { a3[tile][nt] = __builtin_amdgcn_mfma_f32_16x16x32_bf16(xa[tile], bh[nt], a3[tile][nt], 0, 0, 0); a3[tile][nt] = __builtin_amdgcn_mfma_f32_16x16x32_bf16(xa[tile], bl[nt], a3[tile][nt], 0, 0, 0); }
                if (i + 1 < 8) P8_RLD(i + 1);
                if (i + 4 < 8) P8_XLD(i + 4);
#pragma unroll
                for (int j = 0; j < 8; ++j) *(GAS unsigned*)(H2 + (size_t)t * DM + 4 * lane + 256 * j) = hq[j];
                if (lane == 0) { STAT[8 * wave + i] = (f32x4){mean, rstd, mean2, rstd2}; *(GAS f32x2*)(ROWST + t) = (f32x2){mean, rstd}; }
            }
#undef P8_RLD
#undef P8_XLD
        }
#define P8_LG(p_, tile, nt, r) LGP[((p_) * 64 + 16 * (tile) + 4 * g16 + (r)) * 52 + 16 * (nt) + c16]
        if (wave >= 4) {
#pragma unroll
            for (int tile = 0; tile < 4; ++tile)
#pragma unroll
                for (int nt = 0; nt < 3; ++nt)
#pragma unroll
                    for (int r = 0; r < 4; ++r) P8_LG(wave - 4, tile, nt, r) = a3[tile][nt][r];
        }
        __syncthreads();
        if (wave < 4) {
#pragma unroll
            for (int tile = 0; tile < 4; ++tile)
#pragma unroll
                for (int nt = 0; nt < 3; ++nt)
#pragma unroll
                    for (int r = 0; r < 4; ++r) P8_LG(wave, tile, nt, r) = a3[tile][nt][r] + P8_LG(wave, tile, nt, r);
        }
#undef P8_LG
        __syncthreads();
        if (wave == 0) {
            const int t = t0 + lane;
            const LAS float* lp = LGP + lane * 52;
            const f32x4 stt = STAT[lane]; const float ra = stt.y * stt.w, rc = -stt.z * stt.w; const LAS float* uv = UVL;
#define P8_L(c_) (ra * ((((lp[c_] + lp[64 * 52 + (c_)]) + lp[2 * 64 * 52 + (c_)]) + lp[3 * 64 * 52 + (c_)]) - stt.x * uv[c_]) + stt.w * uv[48 + (c_)] + rc * uv[96 + (c_)] + uv[144 + (c_)])
            float gmax = -INFINITY; int grp = 0; float gl[4];
#pragma unroll
            for (int j = 0; j < 4; ++j) { gl[j] = P8_L(j); if (gl[j] > gmax) { gmax = gl[j]; grp = j; } }
            float gs = 0.f;
#pragma unroll
            for (int j = 0; j < 4; ++j) gs += __expf(gl[j] - gmax);
            const float pg = 1.f / gs;
            float e1v = -INFINITY, e2v = -INFINITY; int i1 = 0, i2 = 0;
            for (int j = 0; j < 8; ++j) { const float v = P8_L(4 + grp * 8 + j);
                if (v > e1v) { e2v = e1v; i2 = i1; e1v = v; i1 = j; } else if (v > e2v) { e2v = v; i2 = j; } }
#undef P8_L
            const float w1 = 1.f / (1.f + __expf(e2v - e1v)), w2 = 1.f - w1;
            const int e0 = grp * 8 + i1, e1 = grp * 8 + i2;
            int rank0 = 0, rank1 = 0, mycnt = 0;
            const unsigned long long lt = (1ull << lane) - 1ull;
            for (int e = 0; e < NE; ++e) {
                const unsigned long long m0 = __ballot(e0 == e), m1 = __ballot(e1 == e);
                const int below = __popcll(m0 & lt) + __popcll(m1 & lt);
                if (e0 == e) rank0 = below; if (e1 == e) rank1 = below;
                if (lane == e) mycnt = __popcll(m0) + __popcll(m1);
            }
            if (lane < NE) cntblk[vb * NE + lane] = mycnt;
            tok_e[2 * t] = e0; tok_e[2 * t + 1] = e1; tok_rank[2 * t] = rank0; tok_rank[2 * t + 1] = rank1; tok_w[2 * t] = pg * w1; tok_w[2 * t + 1] = pg * w2;
        }
        __syncthreads();
    }
}
__device__ __forceinline__ void p9_gather(Ctx& F) {
    const int tid = F.tid;
    const int* cntblk = WSP(int, TOK_CNT); const int* tok_e = WSP(int, TOK_E); const int* tok_rank = WSP(int, TOK_RANK); int* tok_slot = WSP(int, TOK_SLOT); int* meta = WSP(int, TOK_META); int* perm = WSP(int, TOK_PERM);
    LAS int* PART = (LAS int*)F.lds;
    LAS int* TOT = PART + 1024;
    for (int vb = blockIdx.x; vb < 256; vb += F.G) {
        int te = 0, tr = 0;
        if (tid < 128) { te = tok_e[vb * 128 + tid]; tr = tok_rank[vb * 128 + tid]; }
        { const int e = tid & 31, part = tid >> 5; int tot = 0, pre = 0;
#pragma unroll
            for (int i = 0; i < 16; ++i) { const int v = 16 * part + i; const int c = cntblk[v * NE + e]; tot += c; if (v < vb) pre += c; }
            PART[part * 32 + e] = tot; PART[512 + part * 32 + e] = pre; }
        __syncthreads();
        if (tid < 32) { int tot = 0, pre = 0;
#pragma unroll
            for (int p = 0; p < 16; ++p) { tot += PART[p * 32 + tid]; pre += PART[512 + p * 32 + tid]; }
            TOT[tid] = tot; TOT[32 + tid] = pre;
            const int ntl = (tot + 255) >> 8; int inc = ntl;
#pragma unroll
            for (int o = 1; o < 32; o <<= 1) { const int n = __shfl_up(inc, o); if (tid >= o) inc += n; }
            const int exc = inc - ntl; TOT[64 + tid] = exc << 8;
            if (vb == 0) { for (int k = 0; k < ntl; ++k) if (exc + k < MAXTILES) meta[1 + exc + k] = tid;
                if (tid == 31) meta[0] = inc < MAXTILES ? inc : MAXTILES; } }
        __syncthreads();
        if (tid < 128) { const int dst = TOT[64 + te] + TOT[32 + te] + tr; tok_slot[vb * 128 + tid] = dst; perm[dst] = vb * 64 + (tid >> 1); }
        if (vb < NE) { const int cnt = TOT[vb], st = TOT[64 + vb], pad = ((cnt + 255) >> 8) << 8; for (int r = cnt + tid; r < pad; r += 512) perm[st + r] = 0; }
        __syncthreads();
    }
}
__device__ __forceinline__ void p12_final(Ctx& F) {
    const bf16* X1 = WSP(bf16, WS_X1); const unsigned char* EO = WSP(unsigned char, WS_R2); const float* MOD = WSP(float, WS_MOD);
    const int* tok_slot = WSP(int, TOK_SLOT); const float* tok_w = WSP(float, TOK_W);
    const int gw = blockIdx.x * 8 + F.wave, NGW = F.G * 8, lane = F.lane;
    const f32x2* ROWST = WSP(f32x2, TOK_ROWST);
    LAS f32x4* L1 = (LAS f32x4*)F.lds;
    L1[F.tid] = *(const GAS f32x4*)(F.ln1_g + 4 * F.tid); L1[512 + F.tid] = *(const GAS f32x4*)(F.ln1_b + 4 * F.tid);
    __syncthreads();
    f32x4 lg[8], lb[8];
#pragma unroll
    for (int j = 0; j < 8; ++j) { lg[j] = *(const GAS f32x4*)(F.ln2_g + 4 * lane + 256 * j); lb[j] = *(const GAS f32x4*)(F.ln2_b + 4 * lane + 256 * j); }
    int s0 = 0, s1 = 0; float w0 = 0.f, w1 = 0.f; f32x2 rs = {0.f, 0.f};
    if (gw < T) { s0 = tok_slot[2 * gw]; s1 = tok_slot[2 * gw + 1]; w0 = tok_w[2 * gw]; w1 = tok_w[2 * gw + 1]; rs = *(const GAS f32x2*)(ROWST + gw); }
    for (int t = gw; t < T; t += NGW) {
        const float* g2 = MOD + (size_t)(t >> 12) * NMOD + 5 * DM;
        unsigned ea[8], eb[8]; v2u xv[8]; f32x4 gg[8];
#pragma unroll
        for (int j = 0; j < 8; ++j) { const int cidx = 4 * lane + 256 * j;
            ea[j] = *(const GAS unsigned*)(EO + (size_t)s0 * DM + cidx); eb[j] = *(const GAS unsigned*)(EO + (size_t)s1 * DM + cidx); xv[j] = *(const GAS v2u*)(X1 + (size_t)t * DM + cidx); gg[j] = *(const GAS f32x4*)(g2 + cidx); }
        const float cw0 = w0, cw1 = w1, m1 = rs.x, r1 = rs.y;
        if (t + NGW < T) { s0 = tok_slot[2 * (t + NGW)]; s1 = tok_slot[2 * (t + NGW) + 1]; w0 = tok_w[2 * (t + NGW)]; w1 = tok_w[2 * (t + NGW) + 1]; rs = *(const GAS f32x2*)(ROWST + t + NGW); }
        f32x4 v[8]; float s = 0.f;
#pragma unroll
        for (int j = 0; j < 8; ++j) {
            const f32x2 a01 = __builtin_amdgcn_cvt_pk_f32_fp8((int)ea[j], false), a23 = __builtin_amdgcn_cvt_pk_f32_fp8((int)ea[j], true), b01 = __builtin_amdgcn_cvt_pk_f32_fp8((int)eb[j], false), b23 = __builtin_amdgcn_cvt_pk_f32_fp8((int)eb[j], true);
            f32x4 f; f.x = cw0 * a01.x + cw1 * b01.x; f.y = cw0 * a01.y + cw1 * b01.y; f.z = cw0 * a23.x + cw1 * b23.x; f.w = cw0 * a23.y + cw1 * b23.y;
            f32x4 x1; x1.x = bf2f(xv[j].x & 0xffffu); x1.y = bf2f(xv[j].x >> 16); x1.z = bf2f(xv[j].y & 0xffffu); x1.w = bf2f(xv[j].y >> 16);
            x1 = (x1 - m1) * r1 * L1[lane + 64 * j] + L1[512 + lane + 64 * j];
            v[j] = x1 * ALPHA + gg[j] * f; s += (v[j].x + v[j].y) + (v[j].z + v[j].w); }
        const float mean = wave_sum(s) * (1.f / DM); float s2 = 0.f;
#pragma unroll
        for (int j = 0; j < 8; ++j) { v[j] = v[j] - mean; s2 += (v[j].x * v[j].x + v[j].y * v[j].y) + (v[j].z * v[j].z + v[j].w * v[j].w); }
        const float rstd = 1.f / sqrtf(wave_sum(s2) * (1.f / DM) + LN_EPS);
#pragma unroll
        for (int j = 0; j < 8; ++j) *(GAS f32x4*)(F.out + (size_t)t * DM + 4 * lane + 256 * j) = v[j] * rstd * lg[j] + lb[j];
    }
}

constexpr int NPHASES = 13;
struct Args { const float* in[23]; float* out; unsigned char* ws; int ph_lo, ph_hi; };
__global__ void __launch_bounds__(512, 2) mk_fwd(Args args) {
    extern __shared__ __attribute__((aligned(16))) unsigned char lds_raw[];
    Ctx F;
    F.lds = (LAS unsigned char*)lds_raw;
    F.tid = threadIdx.x; F.lane = F.tid & 63; F.wave = __builtin_amdgcn_readfirstlane(F.tid >> 6); F.G = gridDim.x;
    F.x = args.in[0]; F.c = args.in[1]; F.ctx = args.in[2]; F.c_ctx = args.in[3]; F.w_ada = args.in[4]; F.b_ada = args.in[5]; F.w_in = args.in[6]; F.w_gate_up = args.in[7]; F.b_gate = args.in[8];
    F.attn_sink = args.in[9]; F.gla_norm_w = args.in[10]; F.w_out = args.in[11]; F.ln1_g = args.in[12]; F.ln1_b = args.in[13]; F.w_rg = args.in[14]; F.b_rg = args.in[15]; F.w_re = args.in[16]; F.b_re = args.in[17];
    F.w_eg = args.in[18]; F.w_eu = args.in[19]; F.w_ed = args.in[20]; F.ln2_g = args.in[21]; F.ln2_b = args.in[22];
    F.out = args.out; F.ws = args.ws;
    volatile LAS unsigned* MISC = (volatile LAS unsigned*)(F.lds + MISC_OFF);
    if (F.tid < 64) MISC[F.tid] = 0u;
    __syncthreads();
    unsigned* ctl = (unsigned*)(F.ws + WS_CTL);
    XcdBarrier bar; bar.bar = ctl + CW_BAR; bar.x = 0; bar.st = nullptr;
    if (MK_N_LAUNCHES == 1) bar = xcd_barrier_post(ctl + CW_BAR, MISC + 8);
    const int lo = args.ph_lo, hi = args.ph_hi;
#define IN(k) (lo <= (k) && (k) < hi)
#define SEAM(k) do { if (IN(k) && IN((k) + 1)) xcd_barrier(bar); } while (0)

#ifndef PROBE_PHASE
#define PROBE_PHASE (-1)
#endif
#define REPS(k) (((k) == PROBE_PHASE) ? 2 : 1)
#define PHASE_BODY(...) do { { int _tz = threadIdx.x; asm volatile("" : "+v"(_tz)); F.tid = _tz; F.lane = _tz & 63; F.wave = __builtin_amdgcn_readfirstlane(_tz >> 6); } __VA_ARGS__; } while (0)
#define PHASE(k, ...) do { if (IN(k)) { PHASE_BODY(__VA_ARGS__); if ((k) == PROBE_PHASE) { xcd_barrier(bar); PHASE_BODY(__VA_ARGS__); } } SEAM(k); } while (0)
    PHASE(0, p0_prologue(F));
    PHASE(1, p1_modreduce(F));
    PHASE(2, p2_router_tables(F); p2_modulate(F));
    PHASE(3, {
        p3_gate(F);
        {
            pg8::Gemm g{WSP(bf16, WS_H8), WSP(bf16, WS_WIN), TA, C_RB, DM / 2, 0}; pg8::StaticOrder S; S.init(TA, C_RB, F.G, (int)blockIdx.x, WGM_P3A);
            EpiProj E{WSP(bf16, WS_R1), WSP(float, WS_ROPE), W8_INV};
            pg8::gemm_phase<EpiProj, pg8::StaticOrder, true, true, true>(F.lds, g, S, E); }
        {
            pg8::Gemm g{WSP(bf16, WS_R2), WSP(bf16, WS_WINR), T, 1024, DM, 0}; pg8::StaticOrder S; S.init(T, 1024, F.G, (int)blockIdx.x, WGM_P3B);
            EpiCols E{WSP(bf16, WS_R1), NPRJ, C_RB};
            pg8::gemm_phase<EpiCols, pg8::StaticOrder, true, true>(F.lds, g, S, E); }
        if (F.G == 256 && blockIdx.x >= 200) xp_convert(F, XP_N0, XP_N0 + XP_N3, (int)blockIdx.x - 200, 56);
    });
    PHASE(4, {
        for (int u = blockIdx.x; u < 512; u += F.G) attn_unit(F, u);
        for (int u = blockIdx.x; u < 256; u += F.G) { int uu = u; if (F.G == 256 && ((u >> 3) & 1)) uu = (u & ~7) | ((9 - (u & 7)) & 7); gla_passA_wide(F, uu); }
        if (F.G == 256 && (blockIdx.x & 3) == 0) xp_convert(F, XP_N0 + XP_N3, XP_ITEMS, (int)blockIdx.x >> 2, 64);
    });
    PHASE(5, { for (int u = blockIdx.x; u < 256; u += F.G) { int uu = u; if (F.G == 256 && ((u >> 3) & 1)) uu = (u & ~7) | (7 - (u & 7)); gla_passC_wide(F, uu); } });
    PHASE(6, p6_gla_out(F));
    PHASE(7, {
        pg8::Gemm g{WSP(bf16, WS_MIX), WSP(bf16, WS_WOUT), T, DM, DM / 2, 0}; pg8::StaticOrder S; S.init(T, DM, F.G, (int)blockIdx.x, WGM_P7);
        EpiX1 E{F.x, WSP(float, WS_MOD), WSP(bf16, WS_X1), W8_INV};
        pg8::gemm_phase<EpiX1, pg8::StaticOrder, true, true, true>(F.lds, g, S, E);
    });
#ifdef PROBE_P8
    if (IN(8)) { PHASE_BODY(p8_ln_route<true>(F)); xcd_barrier(bar); }
#endif
    PHASE(8, p8_ln_route<false>(F));
    PHASE(9, p9_gather(F));
    if (IN(10) || IN(11)) {
        const int* meta = WSP(int, TOK_META); LAS int* tl = (LAS int*)(F.lds + TILE_OFF);
        const int tt = threadIdx.x; if (tt <= MAXTILES) tl[tt] = meta[tt];
        __syncthreads();
    }
    PHASE(10, {
        const LAS int* tl = (const LAS int*)(F.lds + TILE_OFF); const int ntl = __builtin_amdgcn_readfirstlane(tl[0]);
        pg8::Gemm g{WSP(bf16, WS_R2), WSP(bf16, WS_WGU), ntl * 256, DM, DM / 2, (size_t)DM * DM};
        MoeOrderG S; S.nM = ntl; S.nN = 8; S.nwg = ntl * 8; S.G = F.G; S.c = (int)blockIdx.x; S.tile_e = tl + 1;
        {
            LAS int* rt = (LAS int*)(F.lds + TILE_OFF + 1024); const int* perm = WSP(int, TOK_PERM); const int tt = threadIdx.x; pg8::Unit u;
            for (int i = 0; i < MOE_MAXUNITS && S.next(i, u); ++i) if (tt < 256) rt[i * 256 + tt] = perm[256 * u.pm + tt] << 11;
            __syncthreads(); S.rows = rt; }
        EpiSwiGLU E{WSP(unsigned char, WS_R1)};
        pg8::gemm_phase<EpiSwiGLU, MoeOrderG, true, true, true>(F.lds, g, S, E);
    });
    PHASE(11, {
        const LAS int* tl = (const LAS int*)(F.lds + TILE_OFF); const int ntl = __builtin_amdgcn_readfirstlane(tl[0]);
        pg8::Gemm g{WSP(bf16, WS_R1), WSP(bf16, WS_WDN), ntl * 256, DM, EH / 2, (size_t)DM * EH};
        MoeOrder S; S.nM = ntl; S.nN = 8; S.nwg = ntl * 8; S.G = F.G; S.c = (int)blockIdx.x; S.tile_e = tl + 1; S.rows = nullptr;
        EpiPlain E{WSP(unsigned char, WS_R2), DM, W8_INV};
        pg8::gemm_phase<EpiPlain, MoeOrder, true, true, true>(F.lds, g, S, E);
    });
    PHASE(12, p12_final(F));
#undef PHASE
#undef REPS
#undef IN
#undef SEAM
}

extern "C" void kernel_launch(void* const* d_in, const int* in_sizes, int n_in, void* d_out, int out_size, void* d_ws, size_t ws_size, hipStream_t stream) {
    static int grid = 0;
    if (grid == 0) {
        if (n_in != 23 || out_size != T * DM || ws_size < WS_END) { fprintf(stderr, "kernel_launch: unexpected problem (n_in %d, out %d, ws %zu < %zu)\n", n_in, out_size, ws_size, (size_t)WS_END); grid = -1; return; }
        int dev = 0, cus = 0, per_cu = 0;
        if (hipGetDevice(&dev) != hipSuccess || hipDeviceGetAttribute(&cus, hipDeviceAttributeMultiprocessorCount, dev) != hipSuccess) { grid = -1; return; }
        if (hipFuncSetAttribute((const void*)mk_fwd, hipFuncAttributeMaxDynamicSharedMemorySize, LDS_BYTES) != hipSuccess) { fprintf(stderr, "kernel_launch: hipFuncSetAttribute failed\n"); grid = -1; return; }
        if (hipOccupancyMaxActiveBlocksPerMultiprocessor(&per_cu, (const void*)mk_fwd, 512, LDS_BYTES) != hipSuccess || per_cu < 1) fprintf(stderr, "kernel_launch: occupancy query reports %d\n", per_cu);
        (void)hipGetLastError();
        grid = cus > 256 ? 256 : cus;
    }
    if (grid < 0) return;
    if (hipMemsetAsync((char*)d_ws + WS_CTL, 0, CTL_ZERO_BYTES, stream) != hipSuccess) return;
    Args a{};
    for (int i = 0; i < 23; ++i) a.in[i] = (const float*)d_in[i];
    a.out = (float*)d_out; a.ws = (unsigned char*)d_ws;
    for (int li = 0; li < MK_N_LAUNCHES; ++li) {
        a.ph_lo = (MK_N_LAUNCHES == 1) ? 0 : li; a.ph_hi = (MK_N_LAUNCHES == 1) ? NPHASES : li + 1;
        hipLaunchKernelGGL(mk_fwd, dim3(grid), dim3(512), LDS_BYTES, stream, a);
    }
}
```
